# Optimizing an MI355X kernel written in HIP

```python
import jax, jax.numpy as jnp
from jax import lax
import numpy as np

D_MODEL = 2048
BATCH = 1
SEQ = 8192
DEPTH = 1

CTX_LEN = 256
GRID_W = 64
HEAD_DIM = 128
N_Q_HEADS = 16
N_KV_HEADS = 4
Q_PER_KV = N_Q_HEADS // N_KV_HEADS
Q_BLOCK = 128
AXIS_DIM = HEAD_DIM // 2
ROPE_THETA = 10000.0
ATTN_SCALE = HEAD_DIM ** -0.5
GMLP_GROUPS = 16
GMLP_WIDTH = 2048
GMLP_GROUP_DIM = GMLP_WIDTH // GMLP_GROUPS
CHUNK = 128
D_FF = 5632
MACARON_WEIGHT = 0.5
N_MOD = 9
EPS = 1e-6

Q_W = N_Q_HEADS * HEAD_DIM
KV_W = N_KV_HEADS * HEAD_DIM
Q_END = Q_W
K_END = Q_END + KV_W
V_END = K_END + KV_W
GV_END = V_END + 2 * GMLP_WIDTH
IN_W = GV_END + 2 * D_MODEL

kernel_name = "hybrid_gqa_gmlp_macaron_dit_layer"


def rmsnorm(x, w):
    xf = x.astype(jnp.float32)
    y = xf * lax.rsqrt(jnp.mean(xf * xf, axis=-1, keepdims=True) + EPS)
    return (y * w.astype(jnp.float32)).astype(x.dtype)


def layernorm(x, w, b):
    xf = x.astype(jnp.float32)
    mu = jnp.mean(xf, axis=-1, keepdims=True)
    xc = xf - mu
    y = xc * lax.rsqrt(jnp.mean(xc * xc, axis=-1, keepdims=True) + EPS)
    return (y * w.astype(jnp.float32) + b.astype(jnp.float32)).astype(x.dtype)


def modulate(h, shift, scale):
    return h * (1 + scale) + shift


def axial_rope(n_rows):
    row = jnp.broadcast_to(jnp.arange(n_rows, dtype=jnp.float32)[:, None], (n_rows, GRID_W)).reshape(-1)
    col = jnp.broadcast_to(jnp.arange(GRID_W, dtype=jnp.float32)[None, :], (n_rows, GRID_W)).reshape(-1)
    inv_freq = ROPE_THETA ** (-jnp.arange(0, AXIS_DIM, 2, dtype=jnp.float32) / AXIS_DIM)
    ang = jnp.concatenate([row[:, None] * inv_freq, col[:, None] * inv_freq], axis=-1)
    return jnp.cos(ang), jnp.sin(ang)


def apply_rope(x, cos, sin):
    B, S, H, Dh = x.shape
    xr = x.astype(jnp.float32).reshape(B, S, H, Dh // 2, 2)
    x1, x2 = xr[..., 0], xr[..., 1]
    cs, sn = cos[None, :, None, :], sin[None, :, None, :]
    out = jnp.stack([x1 * cs - x2 * sn, x1 * sn + x2 * cs], axis=-1)
    return out.reshape(B, S, H, Dh).astype(x.dtype)


def heads_norm(z, n_heads, gain):
    return rmsnorm(z.reshape(z.shape[0], z.shape[1], n_heads, HEAD_DIM), gain)


def gqa_attend(qi, k_all, v_all):
    s = jnp.einsum('bqkgd,bskd->bkgqs', qi, k_all, preferred_element_type=jnp.float32) * ATTN_SCALE
    p = jax.nn.softmax(s, axis=-1).astype(v_all.dtype)
    return jnp.einsum('bkgqs,bskd->bqkgd', p, v_all)


def latent_attention(q, k, v, k_ctx, v_ctx):
    B, S = q.shape[:2]
    k_all = jnp.concatenate([k_ctx, k], axis=1)
    v_all = jnp.concatenate([v_ctx, v], axis=1)
    qb = q.reshape(B, S // Q_BLOCK, Q_BLOCK, N_KV_HEADS, Q_PER_KV, HEAD_DIM).swapaxes(0, 1)
    o = lax.map(lambda qi: gqa_attend(qi, k_all, v_all), qb)
    return o.swapaxes(0, 1).reshape(B, S, Q_W)


def context_attention(q, k, v):
    B, C = q.shape[:2]
    o = gqa_attend(q.reshape(B, C, N_KV_HEADS, Q_PER_KV, HEAD_DIM), k, v)
    return o.reshape(B, C, Q_W)


def gmlp_branch(z_uv, ln_w, ln_b, w_s, b_s):
    B, N, _ = z_uv.shape
    z = jax.nn.gelu(z_uv, approximate=False)
    u, v = z[..., :GMLP_WIDTH], z[..., GMLP_WIDTH:]
    vn = layernorm(v, ln_w, ln_b).reshape(B, N // CHUNK, CHUNK, GMLP_GROUPS, GMLP_GROUP_DIM)
    mixed = jnp.einsum('gpq,bcqgd->bcpgd', w_s, vn) + b_s.T[:, :, None]
    return u * mixed.reshape(B, N, GMLP_WIDTH)


def merge_branches(attn, gm, gate_logits, b_gate_l, w_ba, w_bg, w_o):
    g = jax.nn.sigmoid(gate_logits.reshape(*gate_logits.shape[:-1], 2, D_MODEL) + b_gate_l)
    return (g[..., 0, :] * (attn @ w_ba) + g[..., 1, :] * (gm @ w_bg)) @ w_o


def ffn_sublayer(x, shift, scale, gate, norm_w, w_in, w_out):
    h = modulate(rmsnorm(x, norm_w), shift, scale)
    a, b = jnp.split(h @ w_in, 2, axis=-1)
    return x + MACARON_WEIGHT * gate * ((jax.nn.silu(a) * b) @ w_out)


def _normal(key, shape, scale):
    return jax.random.normal(key, shape, jnp.float32) * scale


def setup_inputs(seed: int = 0) -> dict:
    key = jax.random.key(seed)
    ks = jax.random.split(key, 24)
    L, D, F = DEPTH, D_MODEL, D_FF
    return {
        "x": _normal(ks[0], (BATCH, SEQ, D), 1.0),
        "c": _normal(ks[1], (BATCH, D), 1.0),
        "ctx": _normal(ks[2], (BATCH, CTX_LEN, D), 1.0),
        "c_ctx": _normal(ks[3], (D,), 1.0),
        "w_mod": _normal(ks[4], (L, D, N_MOD * D), 0.5 * D ** -0.5),
        "b_mod": _normal(ks[5], (L, N_MOD * D), 0.02),
        "norm_w": 1.0 + _normal(ks[6], (L, 3, D), 0.05),
        "w_ffn1_in": _normal(ks[7], (L, D, 2 * F), D ** -0.5),
        "w_ffn1_out": _normal(ks[8], (L, F, D), F ** -0.5),
        "w_ffn2_in": _normal(ks[9], (L, D, 2 * F), D ** -0.5),
        "w_ffn2_out": _normal(ks[10], (L, F, D), F ** -0.5),
        "w_in": _normal(ks[11], (L, D, IN_W), D ** -0.5),
        "b_gate": _normal(ks[12], (L, 2, D), 0.1),
        "q_norm_w": 1.0 + _normal(ks[13], (L, HEAD_DIM), 0.05),
        "k_norm_w": 1.0 + _normal(ks[14], (L, HEAD_DIM), 0.05),
        "gmlp_ln_w": 1.0 + _normal(ks[15], (L, GMLP_WIDTH), 0.05),
        "gmlp_ln_b": _normal(ks[16], (L, GMLP_WIDTH), 0.02),
        "w_spatial": _normal(ks[17], (L, GMLP_GROUPS, CHUNK, CHUNK), 0.5 * CHUNK ** -0.5),
        "b_spatial": 1.0 + _normal(ks[18], (L, GMLP_GROUPS, CHUNK), 0.1),
        "w_branch_attn": _normal(ks[19], (L, Q_W, D), Q_W ** -0.5),
        "w_branch_gmlp": _normal(ks[20], (L, GMLP_WIDTH, D), GMLP_WIDTH ** -0.5),
        "w_out": _normal(ks[21], (L, D, D), D ** -0.5),
        "final_norm_w": 1.0 + _normal(ks[22], (D,), 0.05),
    }


def reference(x, c, ctx, c_ctx, w_mod, b_mod, norm_w, w_ffn1_in, w_ffn1_out, w_ffn2_in, w_ffn2_out,
              w_in, b_gate, q_norm_w, k_norm_w, gmlp_ln_w, gmlp_ln_b, w_spatial, b_spatial,
              w_branch_attn, w_branch_gmlp, w_out, final_norm_w):
    B, S, D = x.shape
    rows = S // GRID_W
    cos, sin = axial_rope(rows)
    sc = jax.nn.silu(c)
    scc = jax.nn.silu(c_ctx)
    for l in range(DEPTH):
        mx = (sc @ w_mod[l] + b_mod[l]).reshape(B, N_MOD, 1, D)
        mc = (scc @ w_mod[l] + b_mod[l]).reshape(1, N_MOD, 1, D)

        x = ffn_sublayer(x, mx[:, 0], mx[:, 1], mx[:, 2], norm_w[l, 0], w_ffn1_in[l], w_ffn1_out[l])
        ctx = ffn_sublayer(ctx, mc[:, 0], mc[:, 1], mc[:, 2], norm_w[l, 0], w_ffn1_in[l], w_ffn1_out[l])

        hx = modulate(rmsnorm(x, norm_w[l, 1]), mx[:, 3], mx[:, 4])
        hc = modulate(rmsnorm(ctx, norm_w[l, 1]), mc[:, 3], mc[:, 4])
        zx = hx @ w_in[l]
        qx = apply_rope(heads_norm(zx[..., :Q_END], N_Q_HEADS, q_norm_w[l]), cos, sin)
        kx = apply_rope(heads_norm(zx[..., Q_END:K_END], N_KV_HEADS, k_norm_w[l]), cos, sin)
        vx = zx[..., K_END:V_END].reshape(B, S, N_KV_HEADS, HEAD_DIM)

        zc_kv = hc @ w_in[l][:, Q_END:V_END]
        kc = heads_norm(zc_kv[..., :KV_W], N_KV_HEADS, k_norm_w[l])
        vc = zc_kv[..., KV_W:].reshape(B, hc.shape[1], N_KV_HEADS, HEAD_DIM)

        attn_x = latent_attention(qx, kx, vx, kc, vc)
        gm_x = gmlp_branch(zx[..., V_END:GV_END], gmlp_ln_w[l], gmlp_ln_b[l], w_spatial[l], b_spatial[l])
        y = merge_branches(attn_x, gm_x, zx[..., GV_END:], b_gate[l],
                           w_branch_attn[l], w_branch_gmlp[l], w_out[l])

        if l < DEPTH - 1:
            qc = heads_norm(hc @ w_in[l][:, :Q_END], N_Q_HEADS, q_norm_w[l])
            zc_rest = hc @ w_in[l][:, V_END:]
            attn_c = context_attention(qc, kc, vc)
            gm_c = gmlp_branch(zc_rest[..., :2 * GMLP_WIDTH], gmlp_ln_w[l], gmlp_ln_b[l],
                               w_spatial[l], b_spatial[l])
            yc = merge_branches(attn_c, gm_c, zc_rest[..., 2 * GMLP_WIDTH:], b_gate[l],
                                w_branch_attn[l], w_branch_gmlp[l], w_out[l])
            ctx = ctx + mc[:, 5] * yc
            ctx = ffn_sublayer(ctx, mc[:, 6], mc[:, 7], mc[:, 8], norm_w[l, 2], w_ffn2_in[l], w_ffn2_out[l])

        x = x + mx[:, 5] * y
        x = ffn_sublayer(x, mx[:, 6], mx[:, 7], mx[:, 8], norm_w[l, 2], w_ffn2_in[l], w_ffn2_out[l])
    return rmsnorm(x, final_norm_w)
```

```cpp
#include <hip/hip_runtime.h>
#include <hip/hip_cooperative_groups.h>
#include <hip/hip_bf16.h>
#include <cstdio>
#include <cstdint>
#include <cmath>
namespace pg8 {
#define PG8_LAS __attribute__((address_space(3)))
typedef unsigned short bf16_t;
typedef short bf16x8 __attribute__((ext_vector_type(8)));
typedef float f32x4 __attribute__((ext_vector_type(4)));
typedef unsigned u32x4 __attribute__((ext_vector_type(4)));
constexpr int BM = 256, BK = 64, HALF = 128, HTB = HALF * BK * 2  , STAGE_BYTES = 8 * HTB, NXCD = 8, WGM = 8;

__host__ __device__ __forceinline__ int lds_byte(int r, int c) { const int st = (r >> 4) * 2 + (c >> 5), rr = r & 15, cc = c & 31, ob = rr * 64 + cc * 2; return st * 1024 + (ob ^ (((ob >> 9) & 1) << 5)); }
__host__ __device__ __forceinline__ void stage_rc(int b, int& R, int& C) { const int st = b / 1024, sb = b % 1024, swz = sb ^ (((sb >> 9) & 1) << 5); R = (st >> 1) * 16 + swz / 64; C = (st & 1) * 32 + (swz % 64) / 2; }
__host__ __device__ __forceinline__ int perm32(int rho) { const int n = rho >> 4, i = rho & 15; return 8 * (i >> 2) + 4 * n + (i & 3); }

struct Unit { int pm, pn; };
struct Gemm { const bf16_t* A; const bf16_t* Bt; int M, N, K; };

struct StaticOrder {
    int nM, nN, nwg, G, c;
    __host__ __device__ void init(int M, int N, int G_, int c_) { nM = M / BM; nN = N / BM; nwg = nM * nN; G = G_; c = c_; }
    __host__ __device__ bool next(int i, Unit& u) const {
        const long L = (long)i * G + c; if (L >= nwg) return false;
        int wgid = (int)L; { const int q = nwg / NXCD, r = nwg % NXCD, xcd = wgid % NXCD, off = wgid / NXCD; wgid = (xcd < r ? xcd * (q + 1) : r * (q + 1) + (xcd - r) * q) + off; }
        const int nig = WGM * nN, gid = wgid / nig, fm = gid * WGM, gsz = (nM - fm) < WGM ? (nM - fm) : WGM;
        u.pm = fm + ((wgid % nig) % gsz); u.pn = (wgid % nig) / gsz; return true;
    }
    __device__ __forceinline__ void a_ready(const Unit&) const {}
    __device__ __forceinline__ void done(const Unit&) const {}
};

typedef float f32x2c_t __attribute__((ext_vector_type(2))); typedef __bf16 bf16x2c_t __attribute__((ext_vector_type(2)));
__device__ __forceinline__ unsigned cvt_pk_bf16(float lo, float hi) { f32x2c_t v = {lo, hi}; bf16x2c_t b = __builtin_convertvector(v, bf16x2c_t); return __builtin_bit_cast(unsigned, b); }
typedef float f32x2 __attribute__((ext_vector_type(2)));
__device__ __forceinline__ f32x2 gelu_pk(f32x2 v) {
    const f32x2 av = __builtin_elementwise_abs(v), d = av * 0.2316418882f + 1.0f;
    f32x2 t; t.x = __builtin_amdgcn_rcpf(d.x); t.y = __builtin_amdgcn_rcpf(d.y);
    f32x2 q = t * 0.5307027145f + (-0.7265760135f); q = q * t + 0.7107068705f; q = q * t + (-0.142248368f); q = q * t + 0.127414796f; q = q * t;
    const f32x2 s = (v * v) * (-0.72134752044f);
    f32x2 e; e.x = __builtin_amdgcn_exp2f(s.x); e.y = __builtin_amdgcn_exp2f(s.y);
    const f32x2 m = v * (q * e), r = v - m;
    f32x2 o; o.x = v.x < 0.f ? m.x : r.x; o.y = v.y < 0.f ? m.y : r.y; return o;
}


typedef unsigned u32x2 __attribute__((ext_vector_type(2)));
__device__ __forceinline__ float bf_lo(unsigned w) { return __uint_as_float(w << 16); }
__device__ __forceinline__ float bf_hi(unsigned w) { return __uint_as_float(w & 0xffff0000u); }
__device__ __forceinline__ float fast_sigmoid(float x) { return __builtin_amdgcn_rcpf(1.0f + __builtin_amdgcn_exp2f(-1.4426950408889634f * x)); }
__device__ __forceinline__ float fast_silu(float x) { return x * fast_sigmoid(x); }
__device__ __forceinline__ u32x4 pack8(const f32x4 v0, const f32x4 v1) { u32x4 w; w.x = cvt_pk_bf16(v0[0], v0[1]); w.y = cvt_pk_bf16(v0[2], v0[3]); w.z = cvt_pk_bf16(v1[0], v1[1]); w.w = cvt_pk_bf16(v1[2], v1[3]); return w; }

struct EpiSwiglu {
    static constexpr bool PERM = true, AFTER_DRAIN = false;
    bf16_t* O; int ldc;
    __device__ __forceinline__ void operator()(const f32x4 (&acc)[2][2][4][2], const Unit& u, int wr, int wc, int fr, int fq) const {
        const int row0 = u.pm * BM + wr * 64 + fr, col0 = u.pn * HALF + wc * 32 + 8 * fq;
#pragma unroll
        for (int ai = 0; ai < 2; ++ai)
#pragma unroll
            for (int m = 0; m < 4; ++m) {
                bf16_t* rowp = O + (size_t)(row0 + ai * HALF + m * 16) * ldc + col0;
                f32x4 h0, h1;
#pragma unroll
                for (int j = 0; j < 4; ++j) { h0[j] = fast_silu(acc[ai][0][m][0][j]) * acc[ai][1][m][0][j]; h1[j] = fast_silu(acc[ai][0][m][1][j]) * acc[ai][1][m][1][j]; }
                *(u32x4*)rowp = pack8(h0, h1);
            }
    }
};

struct EpiResid {
    static constexpr bool PERM = false, AFTER_DRAIN = false;
    const float* src; const float* src2; float* out; const float* mod; const float* bmod; int gate_idx; float coef; int seq_rows;
    __device__ __forceinline__ void operator()(const f32x4 (&acc)[2][2][4][2], const Unit& u, int wr, int wc, int fr, int fq) const {
        const int col0 = u.pn * BM + wc * 32 + 4 * fq;
        const int v = (u.pm * BM >= seq_rows) ? 1 : 0;
        f32x4 g[2][2];
#pragma unroll
        for (int bj = 0; bj < 2; ++bj)
#pragma unroll
            for (int n = 0; n < 2; ++n) { const int c = gate_idx * 2048 + col0 + bj * HALF + n * 16;
                g[bj][n] = (*(const f32x4*)(mod + v * 18432 + c) + *(const f32x4*)(bmod + c)) * coef; }
#pragma unroll
        for (int ai = 0; ai < 2; ++ai)
#pragma unroll
            for (int m = 0; m < 4; ++m) { const int r = u.pm * BM + ai * HALF + wr * 64 + m * 16 + fr;
                const float* s = (r < seq_rows) ? src + (size_t)r * 2048 : src2 + (size_t)(r - seq_rows) * 2048;
                float* o = out + (size_t)r * 2048;
#pragma unroll
                for (int bj = 0; bj < 2; ++bj)
#pragma unroll
                    for (int n = 0; n < 2; ++n) { const int c = col0 + bj * HALF + n * 16;
                        *(f32x4*)(o + c) = *(const f32x4*)(s + c) + g[bj][n] * acc[ai][bj][m][n]; } }
    }
};

template <bool ADD> struct EpiGate {
    static constexpr bool PERM = true, AFTER_DRAIN = false;
    const bf16_t* G; const bf16_t* T; bf16_t* O;
    __device__ __forceinline__ void operator()(const f32x4 (&acc)[2][2][4][2], const Unit& u, int wr, int wc, int fr, int fq) const {
        const int row0 = u.pm * BM + wr * 64 + fr, col0 = u.pn * BM + wc * 32 + 8 * fq;
#pragma unroll
        for (int ai = 0; ai < 2; ++ai)
#pragma unroll
            for (int m = 0; m < 4; ++m)
#pragma unroll
                for (int bj = 0; bj < 2; ++bj) { const size_t off = (size_t)(row0 + ai * HALF + m * 16) * 2048 + col0 + bj * HALF;
                    const u32x4 gw = *(const u32x4*)(G + off);
                    f32x4 v0 = acc[ai][bj][m][0], v1 = acc[ai][bj][m][1];
                    v0[0] *= bf_lo(gw.x); v0[1] *= bf_hi(gw.x); v0[2] *= bf_lo(gw.y); v0[3] *= bf_hi(gw.y);
                    v1[0] *= bf_lo(gw.z); v1[1] *= bf_hi(gw.z); v1[2] *= bf_lo(gw.w); v1[3] *= bf_hi(gw.w);
                    if (ADD) { const u32x4 tw = *(const u32x4*)(T + off);
                        v0[0] += bf_lo(tw.x); v0[1] += bf_hi(tw.x); v0[2] += bf_lo(tw.y); v0[3] += bf_hi(tw.y);
                        v1[0] += bf_lo(tw.z); v1[1] += bf_hi(tw.z); v1[2] += bf_lo(tw.w); v1[3] += bf_hi(tw.w); }
                    *(u32x4*)(O + off) = pack8(v0, v1); }
    }
};

struct EpiInProj {
    static constexpr bool PERM = true, AFTER_DRAIN = false;
    bf16_t *Q, *KA, *VA, *U, *GV, *G0, *G1; float* GVP; const float* rope; const float* qg; const float* kg; const float* bgate; PG8_LAS float* xs; int seq_rows;
    __device__ __forceinline__ void operator()(const f32x4 (&acc)[2][2][4][2], const Unit& u, int wr, int wc, int fr, int fq) const {
        const int pn = u.pn;
        const int row0 = u.pm * BM + wr * 64 + fr, cw = wc * 32 + 8 * fq;
        if (pn < 10) {
#pragma unroll
            for (int ai = 0; ai < 2; ++ai)
#pragma unroll
                for (int m = 0; m < 4; ++m)
#pragma unroll
                    for (int bj = 0; bj < 2; ++bj) { const f32x4 a = acc[ai][bj][m][0], b = acc[ai][bj][m][1];
                        float s = (a[0] * a[0] + a[1] * a[1]) + (a[2] * a[2] + a[3] * a[3]) + (b[0] * b[0] + b[1] * b[1]) + (b[2] * b[2] + b[3] * b[3]);
                        s += __shfl_xor(s, 16); s += __shfl_xor(s, 32);
                        if (fq == 0) xs[((bj * 256) + ai * HALF + wr * 64 + m * 16 + fr) * 4 + wc] = s; }
            asm volatile("s_waitcnt lgkmcnt(0)" ::: "memory"); __builtin_amdgcn_s_barrier(); asm volatile("" ::: "memory");
            const bool isq = pn < 8; const float* gain = isq ? qg : kg;
            const f32x4 g0 = *(const f32x4*)(gain + cw), g1 = *(const f32x4*)(gain + cw + 4);
#pragma unroll
            for (int ai = 0; ai < 2; ++ai)
#pragma unroll
                for (int m = 0; m < 4; ++m) { const int r = row0 + ai * HALF + m * 16;
                    const bool dorope = r < seq_rows;
                    f32x4 cs0 = {1.f, 0.f, 1.f, 0.f}, cs1 = {1.f, 0.f, 1.f, 0.f};
                    if (dorope) { const float* rp = rope + (size_t)r * 128 + cw; cs0 = *(const f32x4*)rp; cs1 = *(const f32x4*)(rp + 4); }
#pragma unroll
                    for (int bj = 0; bj < 2; ++bj) {
                        const f32x4 p = *(const PG8_LAS f32x4*)(xs + ((bj * 256) + ai * HALF + wr * 64 + m * 16 + fr) * 4);
                        const float rinv = __builtin_amdgcn_rsqf(((p[0] + p[1]) + (p[2] + p[3])) * (1.0f / 128.0f) + 1e-6f);
                        f32x4 a = acc[ai][bj][m][0] * rinv * g0, b = acc[ai][bj][m][1] * rinv * g1, ra, rb;
                        ra[0] = a[0] * cs0[0] - a[1] * cs0[1]; ra[1] = a[0] * cs0[1] + a[1] * cs0[0];
                        ra[2] = a[2] * cs0[2] - a[3] * cs0[3]; ra[3] = a[2] * cs0[3] + a[3] * cs0[2];
                        rb[0] = b[0] * cs1[0] - b[1] * cs1[1]; rb[1] = b[0] * cs1[1] + b[1] * cs1[0];
                        rb[2] = b[2] * cs1[2] - b[3] * cs1[3]; rb[3] = b[2] * cs1[3] + b[3] * cs1[2];
                        bf16_t* dst = isq ? Q + (size_t)r * 2048 + (2 * pn + bj) * 128 + cw : KA + (size_t)r * 512 + (2 * (pn - 8) + bj) * 128 + cw;
                        *(u32x4*)dst = pack8(ra, rb); } }
            asm volatile("s_waitcnt lgkmcnt(0)" ::: "memory"); __builtin_amdgcn_s_barrier(); asm volatile("" ::: "memory");
        } else if (pn < 12) {
#pragma unroll
            for (int ai = 0; ai < 2; ++ai)
#pragma unroll
                for (int m = 0; m < 4; ++m)
#pragma unroll
                    for (int bj = 0; bj < 2; ++bj)
                        *(u32x4*)(VA + (size_t)(row0 + ai * HALF + m * 16) * 512 + (2 * (pn - 10) + bj) * 128 + cw) = pack8(acc[ai][bj][m][0], acc[ai][bj][m][1]);
        } else if (pn < 28) {
            const bool isv = pn >= 20; bf16_t* dstb = isv ? GV : U; const int ct = (isv ? pn - 20 : pn - 12) * BM;
#pragma unroll
            for (int ai = 0; ai < 2; ++ai)
#pragma unroll
                for (int m = 0; m < 4; ++m) { const int r = row0 + ai * HALF + m * 16; float s1 = 0.f, s2 = 0.f;
#pragma unroll
                    for (int bj = 0; bj < 2; ++bj) { const f32x4 v0 = acc[ai][bj][m][0], v1 = acc[ai][bj][m][1];
                        const f32x2 a = gelu_pk((f32x2){v0[0], v0[1]}), b = gelu_pk((f32x2){v0[2], v0[3]}), c = gelu_pk((f32x2){v1[0], v1[1]}), d = gelu_pk((f32x2){v1[2], v1[3]});
                        s1 += ((a.x + a.y) + (b.x + b.y)) + ((c.x + c.y) + (d.x + d.y));
                        s2 += ((a.x * a.x + a.y * a.y) + (b.x * b.x + b.y * b.y)) + ((c.x * c.x + c.y * c.y) + (d.x * d.x + d.y * d.y));
                        *(u32x4*)(dstb + (size_t)r * 2048 + ct + bj * HALF + cw) = pack8((f32x4){a.x, a.y, b.x, b.y}, (f32x4){c.x, c.y, d.x, d.y}); }
                    if (isv) { s1 += __shfl_xor(s1, 16); s1 += __shfl_xor(s1, 32); s2 += __shfl_xor(s2, 16); s2 += __shfl_xor(s2, 32);
                        if (fq == 0) *(f32x2*)(GVP + ((size_t)r * 32 + (pn - 20) * 4 + wc) * 2) = (f32x2){s1, s2}; } }
        } else {
            const int gi = pn >= 36 ? 1 : 0; bf16_t* dstb = gi ? G1 : G0; const int ct = (pn - 28 - 8 * gi) * BM;
#pragma unroll
            for (int bj = 0; bj < 2; ++bj) { const f32x4 b0 = *(const f32x4*)(bgate + gi * 2048 + ct + bj * HALF + cw), b1 = *(const f32x4*)(bgate + gi * 2048 + ct + bj * HALF + cw + 4);
#pragma unroll
                for (int ai = 0; ai < 2; ++ai)
#pragma unroll
                    for (int m = 0; m < 4; ++m) { f32x4 v0 = acc[ai][bj][m][0] + b0, v1 = acc[ai][bj][m][1] + b1;
#pragma unroll
                        for (int j = 0; j < 4; ++j) { v0[j] = fast_sigmoid(v0[j]); v1[j] = fast_sigmoid(v1[j]); }
                        *(u32x4*)(dstb + (size_t)(row0 + ai * HALF + m * 16) * 2048 + ct + bj * HALF + cw) = pack8(v0, v1); } }
        }
    }
};
template <class Epi, class Sched, bool ALIGN_EPI = false, bool SP2 = false>
__device__ __forceinline__ void gemm_phase(PG8_LAS unsigned char* lds, const Gemm g, const Sched& S, const Epi& E) {
    int tid_ = threadIdx.x; asm volatile("" : "+v"(tid_));
    const int tid = tid_, wid = __builtin_amdgcn_readfirstlane(tid >> 6), lane = tid & 63, wr = wid >> 2, wc = wid & 3, fr = lane & 15, fq = lane >> 4;
    const int K = g.K, nt = K / BK;
    unsigned voffA[2], voffB[2];
#pragma unroll
    for (int i = 0; i < 2; ++i) { int R, C; stage_rc(tid * 16 + i * 8192, R, C); const int Rb = Epi::PERM ? ((R & ~31) + perm32(R & 31)) : R;
        voffA[i] = (unsigned)(R * K + C) * 2u; voffB[i] = (unsigned)(Rb * K + C) * 2u; }
    const size_t kstep = (size_t)(BK * 2);
    const size_t hstep = (size_t)HALF * K * 2;
    const size_t tstep = 2 * hstep;
    const unsigned ldsw = (unsigned)wid * 1024u;
    const int aoff = lds_byte(wr * 64 + fr, fq * 8), boff = lds_byte(wc * 32 + fr, fq * 8);
#define PG8_SA(b, h) (((b) * 2 + (h)) * HTB)
#define PG8_SB(b, h) ((4 + (b) * 2 + (h)) * HTB)
#define PG8_STAGE(bufoff, gbase, voff) do { _Pragma("unroll") for (int _i = 0; _i < 2; ++_i) \
        __builtin_amdgcn_global_load_lds((const unsigned*)((const char*)(gbase) + (voff)[_i]), (PG8_LAS unsigned*)(lds + (bufoff) + ldsw + _i * 8192), 16, 0, 0); } while (0)
#define PG8_LDA(dst, b, h) do { _Pragma("unroll") for (int m = 0; m < 4; ++m) _Pragma("unroll") for (int k = 0; k < 2; ++k) dst[m][k] = *(const PG8_LAS bf16x8*)(lds + PG8_SA(b, h) + aoff + m * 2048 + k * 1024); } while (0)
#define PG8_LDB(dst, b, h) do { _Pragma("unroll") for (int n = 0; n < 2; ++n) _Pragma("unroll") for (int k = 0; k < 2; ++k) dst[n][k] = *(const PG8_LAS bf16x8*)(lds + PG8_SB(b, h) + boff + n * 2048 + k * 1024); } while (0)
#define PG8_MMA(ai, bj, At, Bt) do { __builtin_amdgcn_s_setprio(1); _Pragma("unroll") for (int m = 0; m < 4; ++m) _Pragma("unroll") for (int n = 0; n < 2; ++n) _Pragma("unroll") for (int k = 0; k < 2; ++k) \
        acc[ai][bj][m][n] = __builtin_amdgcn_mfma_f32_16x16x32_bf16(Bt[n][k], At[m][k], acc[ai][bj][m][n], 0, 0, 0); __builtin_amdgcn_s_setprio(0); } while (0)
#define PG8_WAIT_V(n) asm volatile("s_waitcnt vmcnt(" #n ")" ::: "memory")
#define PG8_WAIT_L(n) asm volatile("s_waitcnt lgkmcnt(" #n ")" ::: "memory")
#define PG8_BAR __builtin_amdgcn_s_barrier()
#define PG8_SCHED __builtin_amdgcn_sched_barrier(0)
    Unit cur, nxt; int ui = 0;
    if (!S.next(0, cur)) return;
    f32x4 acc[2][2][4][2];
#pragma unroll
    for (int a = 0; a < 2; ++a)
#pragma unroll
        for (int b = 0; b < 2; ++b)
#pragma unroll
            for (int m = 0; m < 4; ++m)
#pragma unroll
                for (int n = 0; n < 2; ++n) acc[a][b][m][n] = (f32x4){0.f, 0.f, 0.f, 0.f};
    bf16x8 At[4][2], B0[2][2], B1[2][2];
    const char* cA = (const char*)g.A + (size_t)cur.pm * tstep; const char* cB = (const char*)g.Bt + (size_t)cur.pn * tstep;
    S.a_ready(cur);
    if constexpr (SP2) {
        PG8_STAGE(PG8_SB(0, 0), cB, voffB); PG8_STAGE(PG8_SB(0, 1), cB + hstep, voffB); PG8_STAGE(PG8_SA(0, 0), cA, voffA); PG8_STAGE(PG8_SA(0, 1), cA + hstep, voffA);
        if (wr == 1) PG8_BAR;
        PG8_WAIT_V(2); PG8_BAR;
        PG8_STAGE(PG8_SB(1, 0), cB + kstep, voffB); PG8_STAGE(PG8_SA(1, 0), cA + kstep, voffA); PG8_STAGE(PG8_SB(1, 1), cB + hstep + kstep, voffB);
        PG8_WAIT_V(6); PG8_BAR;
    } else {
        PG8_STAGE(PG8_SB(0, 0), cB, voffB); PG8_STAGE(PG8_SA(0, 0), cA, voffA); PG8_STAGE(PG8_SB(0, 1), cB + hstep, voffB); PG8_STAGE(PG8_SA(0, 1), cA + hstep, voffA);
        if (wr == 1) PG8_BAR;
        PG8_WAIT_V(4); PG8_BAR;
        PG8_STAGE(PG8_SB(1, 0), cB + kstep, voffB); PG8_STAGE(PG8_SA(1, 0), cA + kstep, voffA); PG8_STAGE(PG8_SB(1, 1), cB + hstep + kstep, voffB);
        PG8_WAIT_V(6); PG8_BAR;
    }
    for (;;) {
        const bool has_next = S.next(ui + 1, nxt);
        const char* nA = has_next ? (const char*)g.A + (size_t)nxt.pm * tstep : cA; const char* nB = has_next ? (const char*)g.Bt + (size_t)nxt.pn * tstep : cB;
        for (int t = 0; t < nt; t += 2) {
            const bool last = (t == nt - 2);
            const char* a1 = cA + (size_t)(t + 1) * kstep;
            const char* a2 = last ? nA : cA + (size_t)(t + 2) * kstep; const char* b2 = last ? nB : cB + (size_t)(t + 2) * kstep;
            const char* a3 = a2 + kstep; const char* b3 = b2 + kstep;
            if (last && has_next) S.a_ready(nxt);
            if constexpr (SP2) {
            PG8_LDB(B0, 0, 0); PG8_LDB(B1, 0, 1); PG8_SCHED; PG8_LDA(At, 0, 0); PG8_STAGE(PG8_SA(1, 1), a1 + hstep, voffA);
            PG8_WAIT_V(8); PG8_WAIT_L(0); PG8_BAR; PG8_MMA(0, 0, At, B0); PG8_MMA(0, 1, At, B1); PG8_BAR; PG8_SCHED;
            PG8_LDA(At, 0, 1); PG8_STAGE(PG8_SB(0, 0), b2, voffB); PG8_STAGE(PG8_SB(0, 1), b2 + hstep, voffB); PG8_STAGE(PG8_SA(0, 0), a2, voffA);
            PG8_WAIT_V(8); PG8_WAIT_L(0); PG8_BAR; PG8_MMA(1, 0, At, B0); PG8_MMA(1, 1, At, B1); PG8_BAR; PG8_SCHED;
            PG8_LDB(B0, 1, 0); PG8_LDB(B1, 1, 1); PG8_SCHED; PG8_LDA(At, 1, 0); PG8_STAGE(PG8_SA(0, 1), a2 + hstep, voffA);
            PG8_WAIT_V(8); PG8_WAIT_L(0); PG8_BAR; PG8_MMA(0, 0, At, B0); PG8_MMA(0, 1, At, B1); PG8_BAR; PG8_SCHED;
            PG8_LDA(At, 1, 1); PG8_STAGE(PG8_SB(1, 0), b3, voffB); PG8_STAGE(PG8_SB(1, 1), b3 + hstep, voffB); PG8_STAGE(PG8_SA(1, 0), a3, voffA);
            PG8_WAIT_V(8); PG8_WAIT_L(0); PG8_BAR; PG8_MMA(1, 0, At, B0); PG8_MMA(1, 1, At, B1); PG8_BAR; PG8_SCHED;
            } else {
            PG8_LDB(B0, 0, 0); PG8_SCHED; PG8_LDA(At, 0, 0); PG8_STAGE(PG8_SA(1, 1), a1 + hstep, voffA);
            PG8_WAIT_L(8); PG8_BAR; PG8_WAIT_L(0); PG8_MMA(0, 0, At, B0); PG8_BAR; PG8_SCHED;
            PG8_LDB(B1, 0, 1); PG8_STAGE(PG8_SB(0, 0), b2, voffB);
            PG8_BAR; PG8_WAIT_L(0); PG8_MMA(0, 1, At, B1); PG8_BAR;
            PG8_LDA(At, 0, 1); PG8_STAGE(PG8_SA(0, 0), a2, voffA);
            PG8_BAR; PG8_WAIT_L(0); PG8_MMA(1, 0, At, B0); PG8_BAR; PG8_SCHED;
            PG8_STAGE(PG8_SB(0, 1), b2 + hstep, voffB);
            PG8_WAIT_V(6); PG8_BAR; PG8_MMA(1, 1, At, B1); PG8_BAR;
            PG8_LDB(B0, 1, 0); PG8_SCHED; PG8_LDA(At, 1, 0); PG8_STAGE(PG8_SA(0, 1), a2 + hstep, voffA);
            PG8_WAIT_L(8); PG8_BAR; PG8_WAIT_L(0); PG8_MMA(0, 0, At, B0); PG8_BAR; PG8_SCHED;
            PG8_LDB(B1, 1, 1); PG8_STAGE(PG8_SB(1, 0), b3, voffB);
            PG8_BAR; PG8_WAIT_L(0); PG8_MMA(0, 1, At, B1); PG8_BAR;
            PG8_LDA(At, 1, 1); PG8_STAGE(PG8_SA(1, 0), a3, voffA);
            PG8_BAR; PG8_WAIT_L(0); PG8_MMA(1, 0, At, B0); PG8_BAR; PG8_SCHED;
            PG8_STAGE(PG8_SB(1, 1), b3 + hstep, voffB);
            PG8_WAIT_V(6); PG8_BAR; PG8_MMA(1, 1, At, B1); PG8_BAR;
            }
        }
        if constexpr (ALIGN_EPI) { if (wr == 0) PG8_BAR; }
        if constexpr (!Epi::AFTER_DRAIN) { E(acc, cur, wr, wc, fr, fq); S.done(cur); }
        if (!has_next) break;
#pragma unroll
        for (int a = 0; a < 2; ++a)
#pragma unroll
            for (int b = 0; b < 2; ++b)
#pragma unroll
                for (int m = 0; m < 4; ++m)
#pragma unroll
                    for (int n = 0; n < 2; ++n) acc[a][b][m][n] = (f32x4){0.f, 0.f, 0.f, 0.f};
        cur = nxt; cA = nA; cB = nB; ++ui;
        if constexpr (ALIGN_EPI) { if (wr == 1) PG8_BAR; }
    }
    PG8_WAIT_V(0);
    if constexpr (!ALIGN_EPI) { if (wr == 0) PG8_BAR; }
    PG8_BAR;
    if constexpr (Epi::AFTER_DRAIN) { E.fused(acc, cur, wr, wc, fr, fq, lds, wid, lane); S.done(cur); }
#undef PG8_SA
#undef PG8_SB
#undef PG8_STAGE
#undef PG8_LDA
#undef PG8_LDB
#undef PG8_MMA
#undef PG8_WAIT_V
#undef PG8_WAIT_L
#undef PG8_BAR
#undef PG8_SCHED
}
}
namespace att {
using bf16 = __hip_bfloat16;
constexpr int   D = 128, NW = 8, QBLK = 32, KVBLK = 64;
constexpr float SCALE = 0.088388347648318440f;
constexpr float THR = 8.f;
constexpr int SDEPTH = 2;
constexpr int LDQ = 2048, LDK = 512, LDO = 2048;
constexpr size_t SHM_V = KVBLK * D * 2, SHM_K = KVBLK * D * 2, SHM_ATTN = 2 * SHM_V + 2 * SHM_K + NW * 64 * 4;
using bf16x8 = __attribute__((ext_vector_type(8))) short;
using s16x4  = __attribute__((ext_vector_type(4))) short;
using f32x16 = __attribute__((ext_vector_type(16))) float;
using f32x8  = __attribute__((ext_vector_type(8))) float;
using u32x4  = __attribute__((ext_vector_type(4))) unsigned;
#define KSWZ(row, colB) ((row) * 256 + ((colB) ^ (((row) & 7) << 4)))
#define SBAR() __builtin_amdgcn_sched_barrier(0)
__device__ __forceinline__ int crow(int r, int hi) { return (r & 3) + 8 * (r >> 2) + 4 * hi; }
__device__ __forceinline__ unsigned cvtpk(float lo, float hi) { return pg8::cvt_pk_bf16(lo, hi); }
template <typename TIn> struct Stage;
template <> struct Stage<bf16>  { using T = bf16x8;
  __device__ static __forceinline__ T ld8(const bf16* p) { return *reinterpret_cast<const bf16x8*>(p); }
  __device__ static __forceinline__ bf16x8 tobf(T x) { return x; } };
template <> struct Stage<float> { using T = f32x8;
  __device__ static __forceinline__ T ld8(const float* p) { return *reinterpret_cast<const f32x8*>(p); }
  __device__ static __forceinline__ bf16x8 tobf(T x) {
    u32x4 w = {cvtpk(x[0], x[1]), cvtpk(x[2], x[3]), cvtpk(x[4], x[5]), cvtpk(x[6], x[7])}; return *reinterpret_cast<bf16x8*>(&w); } };

__device__ __forceinline__ void partialSM(f32x16& p0, f32x16& p1, float& m_reg, float& mn, float& alpha) {
  constexpr float C = SCALE * 1.4426950408889634f;
  float pmax = p0[0]; for (int r = 1; r < 16; ++r) pmax = fmaxf(pmax, p0[r]); for (int r = 0; r < 16; ++r) pmax = fmaxf(pmax, p1[r]);
  { auto rr = __builtin_amdgcn_permlane32_swap(__float_as_uint(pmax), __float_as_uint(pmax), false, false);
    pmax = fmaxf(__uint_as_float(rr[0]), __uint_as_float(rr[1])); }
  if (__builtin_expect(__all(pmax - m_reg <= THR / SCALE), 1)) { mn = m_reg; alpha = 1.f; }
  else { mn = fmaxf(m_reg, pmax); alpha = __builtin_amdgcn_exp2f((m_reg - mn) * C); m_reg = mn; }
  float mnC = -mn * C;
  for (int r = 0; r < 16; ++r) p0[r] = fmaf(p0[r], C, mnC); for (int r = 0; r < 16; ++r) p1[r] = fmaf(p1[r], C, mnC);
  for (int r = 0; r < 16; ++r) p0[r] = __builtin_amdgcn_exp2f(p0[r]);
}
__device__ __forceinline__ void finishSM(f32x16& p0, f32x16& p1, float alpha, float& l_reg, bf16x8& pa0, bf16x8& pa1, bf16x8& pa2, bf16x8& pa3) {
  for (int r = 0; r < 16; ++r) p1[r] = __builtin_amdgcn_exp2f(p1[r]);
  float ps = 0; for (int r = 0; r < 16; ++r) ps += p0[r]; for (int r = 0; r < 16; ++r) ps += p1[r];
  { auto rr = __builtin_amdgcn_permlane32_swap(__float_as_uint(ps), __float_as_uint(ps), false, false);
    ps = __uint_as_float(rr[0]) + __uint_as_float(rr[1]); }
  l_reg = l_reg * alpha + ps;
#define PK4(P, BASE, OUT) do { unsigned a0 = cvtpk(P[BASE + 0], P[BASE + 1]), a1 = cvtpk(P[BASE + 2], P[BASE + 3]);   \
    unsigned b0 = cvtpk(P[BASE + 4], P[BASE + 5]), b1 = cvtpk(P[BASE + 6], P[BASE + 7]);                              \
    auto r0 = __builtin_amdgcn_permlane32_swap(a0, b0, false, false); auto r1 = __builtin_amdgcn_permlane32_swap(a1, b1, false, false); \
    u32x4 w = {r0[0], r1[0], r0[1], r1[1]}; OUT = *reinterpret_cast<bf16x8*>(&w); } while (0)
  PK4(p0, 0, pa0); PK4(p0, 8, pa1); PK4(p1, 0, pa2); PK4(p1, 8, pa3);
#undef PK4
}
__device__ __forceinline__ void qkt(f32x16& p0, f32x16& p1, const bf16* Ks, const bf16x8* qr, int r32, int hi) {
  p0 = f32x16{}; p1 = f32x16{};
  for (int d0 = 0; d0 < 8; ++d0) { int cb = (d0 * 16 + hi * 8) * 2;
    bf16x8 b0 = *reinterpret_cast<const bf16x8*>((const char*)Ks + KSWZ(r32, cb));
    bf16x8 b1 = *reinterpret_cast<const bf16x8*>((const char*)Ks + KSWZ(32 + r32, cb));
    p0 = __builtin_amdgcn_mfma_f32_32x32x16_bf16(b0, qr[d0], p0, 0, 0, 0);
    p1 = __builtin_amdgcn_mfma_f32_32x32x16_bf16(b1, qr[d0], p1, 0, 0, 0); }
}
__device__ __forceinline__ int v_st(int k, int c) { const int kk = (k & ~0xC) | ((k & 4) << 1) | ((k & 8) >> 1); return ((kk >> 3) * 4 + (c >> 5)) * 512 + ((kk & 7) * 32 + (c & 31)) * 2; }
__device__ __forceinline__ int v_rd_base(int lane) { return ((lane & 3) << 3) | (((lane >> 2) & 3) << 6) | (((lane >> 4) & 1) << 5) | (((lane >> 5) & 1) << 8); }
constexpr int v_rd_off(int d0, int ks, int half) { return d0 * 512 + ks * 4096 + half * 2048; }
template <int OFF> __device__ __forceinline__ s16x4 tr_read(int vb) {
  s16x4 r; asm volatile("ds_read_b64_tr_b16 %0, %1 offset:%2" : "=&v"(r) : "v"(vb), "i"(OFF) : "memory"); return r;
}
template <int D0> __device__ __forceinline__ void pv_one(f32x16& od, int vb, bf16x8 pa0, bf16x8 pa1, bf16x8 pa2, bf16x8 pa3) {
  const s16x4 l0 = tr_read<v_rd_off(D0, 0, 0)>(vb), h0 = tr_read<v_rd_off(D0, 0, 1)>(vb), l1 = tr_read<v_rd_off(D0, 1, 0)>(vb), h1 = tr_read<v_rd_off(D0, 1, 1)>(vb);
  const s16x4 l2 = tr_read<v_rd_off(D0, 2, 0)>(vb), h2 = tr_read<v_rd_off(D0, 2, 1)>(vb), l3 = tr_read<v_rd_off(D0, 3, 0)>(vb), h3 = tr_read<v_rd_off(D0, 3, 1)>(vb);
  asm volatile("s_waitcnt lgkmcnt(0)" ::: "memory"); SBAR();
#define PK(L, H) (bf16x8){L[0], L[1], L[2], L[3], H[0], H[1], H[2], H[3]}
  od = __builtin_amdgcn_mfma_f32_32x32x16_bf16(pa0, PK(l0, h0), od, 0, 0, 0);
  od = __builtin_amdgcn_mfma_f32_32x32x16_bf16(pa1, PK(l1, h1), od, 0, 0, 0);
  od = __builtin_amdgcn_mfma_f32_32x32x16_bf16(pa2, PK(l2, h2), od, 0, 0, 0);
  od = __builtin_amdgcn_mfma_f32_32x32x16_bf16(pa3, PK(l3, h3), od, 0, 0, 0);
#undef PK
}
__device__ __forceinline__ void pv_d0(f32x16* o, int vb, bf16x8 pa0, bf16x8 pa1, bf16x8 pa2, bf16x8 pa3) {
  pv_one<0>(o[0], vb, pa0, pa1, pa2, pa3); pv_one<1>(o[1], vb, pa0, pa1, pa2, pa3); pv_one<2>(o[2], vb, pa0, pa1, pa2, pa3); pv_one<3>(o[3], vb, pa0, pa1, pa2, pa3);
}
template <typename TQ>
__device__ __forceinline__ void attn_dense_body(const TQ* __restrict__ Qb, const bf16* __restrict__ Kh, const bf16* __restrict__ Vh,
                                                bf16* __restrict__ Ob, int seq, char* lds) {
  using St = Stage<bf16>; using SQ = Stage<TQ>;
  int tid_ = threadIdx.x; asm volatile("" : "+v"(tid_));
  const int tid = tid_, wid = tid >> 6, lane = tid & 63, r32 = lane & 31, hi = lane >> 5;
  bf16* V_lds = (bf16*)lds; bf16* K_lds = (bf16*)(lds + 2 * SHM_V);
  float* ws = (float*)(lds + 2 * SHM_V + 2 * SHM_K) + wid * 64; float* li_l = ws; float* al_l = ws + 32;
  float m_reg = -1e30f, l_reg = 0; f32x16 o[4] = {}; bf16x8 qr[8];
  const TQ* Qw = Qb + (long)(wid * QBLK + r32) * LDQ + hi * 8;
#pragma unroll
  for (int d0 = 0; d0 < 8; ++d0) qr[d0] = SQ::tobf(SQ::ld8(Qw + d0 * 16));
  const int sr = tid >> 4, sc = (tid & 15) * 8, vst0 = v_st(sr, sc), vst1 = v_st(32 + sr, sc);
  const int vb0 = (int)(uintptr_t)V_lds + v_rd_base(lane);
  struct { typename St::T vs0, vs1, ks0, ks1; } sr_[SDEPTH];
#define SLOAD(i, k0) do { sr_[i].vs0 = St::ld8(&Vh[(long)((k0) + sr) * LDK + sc]); sr_[i].vs1 = St::ld8(&Vh[(long)((k0) + 32 + sr) * LDK + sc]); \
    sr_[i].ks0 = St::ld8(&Kh[(long)((k0) + sr) * LDK + sc]); sr_[i].ks1 = St::ld8(&Kh[(long)((k0) + 32 + sr) * LDK + sc]); } while (0)
#define SWRITE(b, i) do { *(bf16x8*)((char*)V_lds + (b) * SHM_V + vst0) = St::tobf(sr_[i].vs0);          \
    *(bf16x8*)((char*)V_lds + (b) * SHM_V + vst1) = St::tobf(sr_[i].vs1); int kc = sc * 2;               \
    *(bf16x8*)((char*)K_lds + (b) * SHM_K + KSWZ(sr, kc)) = St::tobf(sr_[i].ks0);                       \
    *(bf16x8*)((char*)K_lds + (b) * SHM_K + KSWZ(32 + sr, kc)) = St::tobf(sr_[i].ks1); } while (0)
#define SWAIT() do { if constexpr (SDEPTH == 2) asm volatile("s_waitcnt vmcnt(4)" ::: "memory"); else asm volatile("s_waitcnt vmcnt(0)" ::: "memory"); } while (0)
#define RESC(a) do { if (__any((a) < 1.f)) { if (hi == 0) al_l[r32] = (a); asm volatile("s_waitcnt lgkmcnt(0)" ::: "memory"); \
    for (int d = 0; d < 4; ++d) for (int r = 0; r < 16; ++r) o[d][r] *= al_l[crow(r, hi)]; } } while (0)
  f32x16 pA0, pA1, pB0, pB1; float mnA, mnB, alA, alB; bf16x8 pa0, pa1, pa2, pa3; const int NT = seq / KVBLK;
  constexpr int SE = 0, SO = SDEPTH - 1;
  SLOAD(SE, 0); asm volatile("s_waitcnt vmcnt(0)" ::: "memory"); SWRITE(0, SE); __syncthreads();
  qkt(pA0, pA1, K_lds, qr, r32, hi); partialSM(pA0, pA1, m_reg, mnA, alA);
  SLOAD(SO, KVBLK); if constexpr (SDEPTH == 2) { if (2 < NT) SLOAD(SE, 2 * KVBLK); }
  SWAIT(); SWRITE(1, SO); __syncthreads();
  for (int j = 1; j + 1 < NT; j += 2) {
    SBAR(); qkt(pB0, pB1, (bf16*)((char*)K_lds + SHM_K), qr, r32, hi);
    finishSM(pA0, pA1, alA, l_reg, pa0, pa1, pa2, pa3); SBAR();
    SLOAD(SO, (j + SDEPTH) * KVBLK); SBAR();
    pv_d0(o, vb0, pa0, pa1, pa2, pa3); partialSM(pB0, pB1, m_reg, mnB, alB);
    __syncthreads(); SWAIT(); SWRITE(0, SE);
    RESC(alB); __syncthreads();
    SBAR(); qkt(pA0, pA1, K_lds, qr, r32, hi);
    finishSM(pB0, pB1, alB, l_reg, pa0, pa1, pa2, pa3); SBAR();
    if (SDEPTH == 1 || j + 3 < NT) SLOAD(SE, (j + 1 + SDEPTH) * KVBLK); SBAR();
    pv_d0(o, vb0 + (int)SHM_V, pa0, pa1, pa2, pa3); partialSM(pA0, pA1, m_reg, mnA, alA);
    __syncthreads(); SWAIT(); SWRITE(1, SO);
    RESC(alA); __syncthreads();
  }
  SBAR(); qkt(pB0, pB1, (bf16*)((char*)K_lds + SHM_K), qr, r32, hi);
  finishSM(pA0, pA1, alA, l_reg, pa0, pa1, pa2, pa3); SBAR();
  pv_d0(o, vb0, pa0, pa1, pa2, pa3); partialSM(pB0, pB1, m_reg, mnB, alB);
  __syncthreads(); RESC(alB);
  finishSM(pB0, pB1, alB, l_reg, pa0, pa1, pa2, pa3); SBAR();
  pv_d0(o, vb0 + (int)SHM_V, pa0, pa1, pa2, pa3);
  if (hi == 0) li_l[r32] = l_reg; asm volatile("s_waitcnt lgkmcnt(0)" ::: "memory");
  float rli[16];
#pragma unroll
  for (int r = 0; r < 16; ++r) rli[r] = __builtin_amdgcn_rcpf(li_l[crow(r, hi)]);
  bf16* Ow = Ob + (long)(wid * QBLK) * LDO;
#pragma unroll
  for (int r = 0; r < 16; ++r) { int orow = crow(r, hi);
    for (int d0 = 0; d0 < 4; ++d0) Ow[(long)orow * LDO + d0 * 32 + r32] = __float2bfloat16(o[d0][r] * rli[r]); }
#undef SLOAD
#undef SWRITE
#undef SWAIT
#undef RESC
}
}

namespace cg = cooperative_groups;
#define LAS __attribute__((address_space(3)))
typedef pg8::bf16_t bfr;
typedef float f32x4 __attribute__((ext_vector_type(4)));
typedef float f32x2 __attribute__((ext_vector_type(2)));
typedef unsigned u32x4 __attribute__((ext_vector_type(4)));
typedef unsigned u32x2 __attribute__((ext_vector_type(2)));
typedef short bf16x8 __attribute__((ext_vector_type(8)));

constexpr int DM = 2048, SEQ = 8192, CTXL = 256, MTOT = SEQ + CTXL, DFF = 5632, INW = 11264, NMODW = 9 * DM  ;
constexpr int NWAVES = 8, NTHREADS = 512;
constexpr float EPS = 1e-6f;

constexpr size_t MiB = 1u << 20;
constexpr size_t WS_CTL = 0, CTL_ZERO_BYTES = 512 * 1024;
constexpr size_t CTL_MOD = 64 * 1024;
constexpr size_t WS_W1T = 2 * MiB, WS_W2T = 46 * MiB, WS_WINT = 68 * MiB, WS_W3T = 112 * MiB, WS_W4T = 156 * MiB;
constexpr size_t WS_WBAT = 178 * MiB, WS_WBGT = 186 * MiB, WS_WOT = 194 * MiB;
constexpr size_t WS_ROPE = 202 * MiB, WS_GVP = 206 * MiB;
constexpr size_t WS_H = 208 * MiB, WS_HID = 241 * MiB, WS_Q = 241 * MiB, WS_U = 273 * MiB, WS_T1 = WS_Q;
constexpr size_t WS_X1 = 332 * MiB, WS_ATT = 398 * MiB, WS_KA = 430 * MiB, WS_VA = 439 * MiB;
constexpr size_t WS_GV = 448 * MiB, WS_MRG = WS_GV, WS_G0 = 480 * MiB, WS_G1 = 512 * MiB, WS_END = 544 * MiB;
static_assert(WS_HID + (size_t)MTOT * DFF * 2 <= WS_X1 && WS_X1 + (size_t)MTOT * DM * 4 <= WS_ATT && WS_H + (size_t)MTOT * DM * 2 <= WS_HID, "ws map");
static_assert(WS_KA + (size_t)MTOT * 512 * 2 <= WS_VA && WS_VA + (size_t)MTOT * 512 * 2 <= WS_GV && CTL_MOD + 2 * NMODW * 4 <= CTL_ZERO_BYTES, "ws map");

constexpr int RING_BYTES = 131072, XS_OFF = RING_BYTES, MISC_OFF = XS_OFF + 8192, LDS_BYTES = 147456;
constexpr int CW_BAR = 1024;

__device__ __forceinline__ float wave_sum(float v) {
#pragma unroll
    for (int o = 1; o < 64; o <<= 1) v += __shfl_xor(v, o);
    return v;
}
__device__ __forceinline__ unsigned f2bf(float f) { unsigned u = __builtin_bit_cast(unsigned, f); return (u + 0x7fffu + ((u >> 16) & 1u)) >> 16; }
__device__ __forceinline__ unsigned pk2(float lo, float hi) { return pg8::cvt_pk_bf16(lo, hi); }
__device__ __forceinline__ float bflo(unsigned w) { return __uint_as_float(w << 16); }
__device__ __forceinline__ float bfhi(unsigned w) { return __uint_as_float(w & 0xffff0000u); }

#define XB_TMO      128
#define XB_XCNT(j)  (256  + 64 * (j))
#define XB_XSUB(j)  (1280 + 64 * (j))
#define XB_XGEN(j)  (2304 + 64 * (j))
#define XB_TOP      3328
#define XB_TOPGEN   3392
#define XCD_BAR_WORDS 3456
#define XB_SPIN_CAP (1u << 18)

__device__ __forceinline__ unsigned xb_ld(unsigned* p)              { return __hip_atomic_load(p, __ATOMIC_RELAXED, __HIP_MEMORY_SCOPE_AGENT); }
__device__ __forceinline__ unsigned xb_add(unsigned* p, unsigned v) { return __hip_atomic_fetch_add(p, v, __ATOMIC_RELAXED, __HIP_MEMORY_SCOPE_AGENT); }
__device__ __forceinline__ unsigned xb_xcc_id() { return (unsigned)__builtin_amdgcn_s_getreg((3 << 11) | 20) & 0xFu; }
#define XB_SPIN(cond, bar) do { unsigned _sp = 0; while (cond) { __builtin_amdgcn_s_sleep(1); \
    if ((++_sp & 255u) == 0u) { if (xb_ld(&(bar)[XB_TMO])) break; if (_sp > XB_SPIN_CAP) { atomicAdd(&(bar)[XB_TMO], 1u); break; } } } } while (0)

struct XcdBarrier {
    unsigned* bar; unsigned x;
    volatile LAS unsigned* st;
};

__device__ __forceinline__ XcdBarrier xcd_barrier_post(unsigned* bar, volatile LAS unsigned* st) {
    XcdBarrier b; b.bar = bar; b.x = xb_xcc_id(); b.st = st;
    if (threadIdx.x == 0) (void)xb_add(&bar[XB_XCNT(b.x)], 1u);
    return b;
}
__device__ __forceinline__ void xcd_barrier_complete(unsigned* bar, unsigned x, unsigned& nloc, unsigned& nx) {
    const unsigned G = gridDim.x * gridDim.y * gridDim.z;
    unsigned sum, cnt, mine, sp = 0u;
    for (;;) {
        sum = 0u; cnt = 0u; mine = 0u;
#pragma unroll
        for (unsigned j = 0; j < 16; ++j) { const unsigned c = xb_ld(&bar[XB_XCNT(j)]); sum += c; cnt += (c > 0u) ? 1u : 0u; mine = (j == x) ? c : mine; }
        if (sum == G) break;
        __builtin_amdgcn_s_sleep(1);
        if ((++sp & 255u) == 0u) { if (xb_ld(&bar[XB_TMO])) break; if (sp > XB_SPIN_CAP) { atomicAdd(&bar[XB_TMO], 1u); break; } }
    }
    nloc = mine > 0u ? mine : 1u; nx = cnt > 0u ? cnt : 1u;
}

__device__ __forceinline__ void xcd_barrier(const XcdBarrier& b) {
    asm volatile("s_waitcnt vmcnt(0)" ::: "memory");
    __syncthreads();
    if (threadIdx.x == 0) {
        unsigned* bar = b.bar;
        __builtin_amdgcn_s_waitcnt(0);
        unsigned nloc = b.st[0], nx = b.st[1];
        if (nloc == 0u) { xcd_barrier_complete(bar, b.x, nloc, nx); b.st[0] = nloc; b.st[1] = nx; }
        const unsigned old = xb_add(&bar[XB_XSUB(b.x)], 1u);
        const unsigned gen = old / nloc;
        if (old + 1u == (gen + 1u) * nloc) {
            __builtin_amdgcn_fence(__ATOMIC_RELEASE, "agent");
            asm volatile("s_waitcnt vmcnt(0)" ::: "memory");
            const unsigned og = xb_add(&bar[XB_TOP], 1u);
            const unsigned tg = og / nx;
            if (og + 1u == (tg + 1u) * nx) xb_add(&bar[XB_TOPGEN], 1u);
            else XB_SPIN(xb_ld(&bar[XB_TOPGEN]) == tg, bar);
            __builtin_amdgcn_fence(__ATOMIC_ACQUIRE, "agent");
            xb_add(&bar[XB_XGEN(b.x)], 1u);
            asm volatile("s_waitcnt vmcnt(0)" ::: "memory");
        } else {
            XB_SPIN(xb_ld(&bar[XB_XGEN(b.x)]) == gen, bar);
            __builtin_amdgcn_fence(__ATOMIC_ACQUIRE, "agent");
            asm volatile("s_waitcnt vmcnt(0)" ::: "memory");
        }
    }
    __syncthreads();
}

template <int MODE> __device__ __forceinline__ void transpose_item(const float* __restrict__ W, int K, int N, bfr* WT, LAS float* scr, int item, int lane) {
    const int nblk = N / 32, kb = item / nblk, nb = item % nblk, k0 = 64 * kb, n0 = 32 * nb;
    int d0 = n0;
    if (MODE == 1) { const int F = N / 2; const int nn = n0 < F ? n0 : n0 - F; d0 = (nn / 128) * 256 + (n0 < F ? 0 : 128) + (nn % 128); }
#pragma unroll 8
    for (int i = 0; i < 32; ++i) { const int kk = 2 * i + (lane >> 5); scr[kk * 33 + (lane & 31)] = W[(size_t)(k0 + kk) * N + n0 + (lane & 31)]; }
    asm volatile("s_waitcnt lgkmcnt(0)" ::: "memory");
    const int c = lane & 7;
#pragma unroll
    for (int j = 0; j < 4; ++j) { const int n = (lane >> 3) + 8 * j; const LAS float* s = scr + (8 * c) * 33 + n;
        u32x4 o; o.x = pk2(s[0 * 33], s[1 * 33]); o.y = pk2(s[2 * 33], s[3 * 33]); o.z = pk2(s[4 * 33], s[5 * 33]); o.w = pk2(s[6 * 33], s[7 * 33]);
        *(u32x4*)(WT + (size_t)(d0 + n) * K + k0 + 8 * c) = o; }
    asm volatile("s_waitcnt lgkmcnt(0)" ::: "memory");
}

__device__ __forceinline__ void norm_mod_row(const float* xrow, const float* nw, const float* ms, const float* bs, const float* mc, const float* bc, bfr* orow, int lane) {
    const f32x4* xr = (const f32x4*)xrow + lane;
    f32x4 v[8]; float ss = 0.f;
#pragma unroll
    for (int j = 0; j < 8; ++j) { v[j] = xr[64 * j]; ss += (v[j][0] * v[j][0] + v[j][1] * v[j][1]) + (v[j][2] * v[j][2] + v[j][3] * v[j][3]); }
    const float rinv = 1.0f / sqrtf(wave_sum(ss) * (1.0f / DM) + EPS);
    u32x2* o8 = (u32x2*)orow + lane;
#pragma unroll
    for (int j = 0; j < 8; ++j) { const int c4 = lane + 64 * j;
        const f32x4 w = ((const f32x4*)nw)[c4], sh = ((const f32x4*)ms)[c4] + ((const f32x4*)bs)[c4], sc = ((const f32x4*)mc)[c4] + ((const f32x4*)bc)[c4];
        const f32x4 y = (v[j] * rinv * w) * (sc + 1.0f) + sh;
        u32x2 p; p.x = pk2(y[0], y[1]); p.y = pk2(y[2], y[3]); o8[64 * j] = p; }
}

__device__ __forceinline__ void spatial_unit(LAS unsigned char* lds, int c, int g, const bfr* GV, const float* GVP, const bfr* U, bfr* GM,
                                             const float* wsp, const float* bsp, const float* lnw, const float* lnb, int tid, int lane, int wave) {
    constexpr int PITCH = 136;
    LAS bfr* Al = (LAS bfr*)lds;
    LAS bfr* Vt = (LAS bfr*)(lds + 128 * PITCH * 2);
    LAS float* st = (LAS float*)(lds + 2 * 128 * PITCH * 2);
    const int R0 = c * 128, C0 = g * 128;
    if (tid < 128) { const float* p = GVP + (size_t)(R0 + tid) * 64; float s1 = 0.f, s2 = 0.f;
#pragma unroll 8
        for (int k = 0; k < 32; ++k) { s1 += p[2 * k]; s2 += p[2 * k + 1]; }
        const float mu = s1 * (1.0f / 2048.0f), var = s2 * (1.0f / 2048.0f) - mu * mu;
        st[2 * tid] = mu; st[2 * tid + 1] = 1.0f / sqrtf(fmaxf(var, 0.f) + EPS); }
#pragma unroll
    for (int i = 0; i < 4; ++i) { const int e = tid + 512 * i, p = e >> 4, q0 = (e & 15) * 8; const float* w = wsp + ((size_t)g * 128 + p) * 128 + q0;
        const f32x4 a = *(const f32x4*)w, b = *(const f32x4*)(w + 4);
        u32x4 o; o.x = pk2(a[0], a[1]); o.y = pk2(a[2], a[3]); o.z = pk2(b[0], b[1]); o.w = pk2(b[2], b[3]);
        *(LAS u32x4*)(Al + p * PITCH + q0) = o; }
    __syncthreads();
#pragma unroll
    for (int i = 0; i < 4; ++i) { const int e = tid + 512 * i, q = e >> 4, d0 = (e & 15) * 8;
        const u32x4 x = *(const u32x4*)(GV + (size_t)(R0 + q) * 2048 + C0 + d0);
        const float mu = st[2 * q], rs = st[2 * q + 1];
        const f32x4 lw0 = *(const f32x4*)(lnw + C0 + d0), lw1 = *(const f32x4*)(lnw + C0 + d0 + 4), lb0 = *(const f32x4*)(lnb + C0 + d0), lb1 = *(const f32x4*)(lnb + C0 + d0 + 4);
        float v[8] = {bflo(x.x), bfhi(x.x), bflo(x.y), bfhi(x.y), bflo(x.z), bfhi(x.z), bflo(x.w), bfhi(x.w)};
#pragma unroll
        for (int j = 0; j < 8; ++j) { const float lw = j < 4 ? lw0[j & 3] : lw1[j & 3], lb = j < 4 ? lb0[j & 3] : lb1[j & 3];
            Vt[(d0 + j) * PITCH + q] = (bfr)f2bf((v[j] - mu) * rs * lw + lb); } }
    __syncthreads();
    f32x4 acc[8];
#pragma unroll
    for (int db = 0; db < 8; ++db) acc[db] = (f32x4){0.f, 0.f, 0.f, 0.f};
    const int l15 = lane & 15, l4 = lane >> 4;
#pragma unroll
    for (int kb = 0; kb < 4; ++kb) {
        const bf16x8 bfrag = *(const LAS bf16x8*)(Al + (16 * wave + l15) * PITCH + kb * 32 + 8 * l4);
#pragma unroll
        for (int db = 0; db < 8; ++db) { const bf16x8 afrag = *(const LAS bf16x8*)(Vt + (16 * db + l15) * PITCH + kb * 32 + 8 * l4);
            acc[db] = __builtin_amdgcn_mfma_f32_16x16x32_bf16(afrag, bfrag, acc[db], 0, 0, 0); }
    }
    const int pl = 16 * wave + l15; const float bp = bsp[g * 128 + pl];
    const size_t rowoff = (size_t)(R0 + pl) * 2048 + C0 + 4 * l4;
#pragma unroll
    for (int db = 0; db < 8; ++db) { const u32x2 uw = *(const u32x2*)(U + rowoff + 16 * db);
        u32x2 o; o.x = pk2(bflo(uw.x) * (acc[db][0] + bp), bfhi(uw.x) * (acc[db][1] + bp)); o.y = pk2(bflo(uw.y) * (acc[db][2] + bp), bfhi(uw.y) * (acc[db][3] + bp));
        *(u32x2*)(GM + rowoff + 16 * db) = o; }
    __syncthreads();
}

struct InProjOrder {
    pg8::StaticOrder base; int nextra;
    __device__ __forceinline__ bool next(int i, pg8::Unit& u) const {
        if (base.next(i, u)) return true;
        const long L = (long)i * base.G + base.c - base.nwg; if (L >= nextra) return false;
        u.pm = 32; u.pn = 8 + (int)L; return true;
    }
    __device__ __forceinline__ void a_ready(const pg8::Unit&) const {}
    __device__ __forceinline__ void done(const pg8::Unit&) const {}
};


#ifndef DBG_DUMP
#define DBG_DUMP 0
#endif
#define BFV(p, i) __uint_as_float(((unsigned)(p)[i]) << 16)
#define DUMP_AND_RETURN(EXPR) do { for (size_t e_ = (size_t)bx * NTHREADS + tid; e_ < (size_t)SEQ * DM; e_ += (size_t)G * NTHREADS) { const size_t r = e_ / DM, c = e_ % DM; (void)r; (void)c; a.out[e_] = (EXPR); } return; } while (0)
struct Args { const float* in[23]; float* out; unsigned char* ws; };

__global__ void __launch_bounds__(NTHREADS, 2) fwd_kernel(Args a) {
    extern __shared__ __attribute__((aligned(16))) unsigned char lds_raw[];
    LAS unsigned char* lds = (LAS unsigned char*)lds_raw;
    cg::grid_group grid = cg::this_grid();
    const int tid = threadIdx.x, lane = tid & 63, wave = __builtin_amdgcn_readfirstlane(tid >> 6);
    const int G = gridDim.x, bx = blockIdx.x;
    const int vcu = (G % 8 == 0) ? (bx % 8) * (G / 8) + bx / 8 : bx;
    const int gw = vcu * NWAVES + wave, NGW = G * NWAVES;
    unsigned char* ws = a.ws;
    const float* x = a.in[0]; const float* cvec = a.in[1]; const float* ctx = a.in[2]; const float* cctx = a.in[3];
    const float* w_mod = a.in[4]; const float* b_mod = a.in[5]; const float* norm_w = a.in[6];
    const float* w_spatial = a.in[17]; const float* b_spatial = a.in[18];
    float* MOD = (float*)(ws + WS_CTL + CTL_MOD);
    bfr* W1T = (bfr*)(ws + WS_W1T); bfr* W2T = (bfr*)(ws + WS_W2T); bfr* WINT = (bfr*)(ws + WS_WINT); bfr* W3T = (bfr*)(ws + WS_W3T); bfr* W4T = (bfr*)(ws + WS_W4T);
    bfr* WBAT = (bfr*)(ws + WS_WBAT); bfr* WBGT = (bfr*)(ws + WS_WBGT); bfr* WOT = (bfr*)(ws + WS_WOT);
    float* ROPE = (float*)(ws + WS_ROPE); float* GVP = (float*)(ws + WS_GVP);
    bfr* H = (bfr*)(ws + WS_H); bfr* HID = (bfr*)(ws + WS_HID); bfr* Qb = (bfr*)(ws + WS_Q); bfr* Ub = (bfr*)(ws + WS_U); bfr* T1 = (bfr*)(ws + WS_T1);
    float* X1 = (float*)(ws + WS_X1); bfr* ATT = (bfr*)(ws + WS_ATT); bfr* KA = (bfr*)(ws + WS_KA); bfr* VA = (bfr*)(ws + WS_VA);
    bfr* GVb = (bfr*)(ws + WS_GV); bfr* MRG = (bfr*)(ws + WS_MRG); bfr* G0 = (bfr*)(ws + WS_G0); bfr* G1 = (bfr*)(ws + WS_G1);

    if (tid < 2) ((volatile LAS unsigned*)(lds + MISC_OFF))[tid] = 0u;
    __syncthreads();
    XcdBarrier xbar = xcd_barrier_post((unsigned*)(ws + WS_CTL) + CW_BAR, (volatile LAS unsigned*)(lds + MISC_OFF));
#define GRID_SYNC() xcd_barrier(xbar)
    grid.sync();
#define GRID_SYNC_CG() do { asm volatile("s_waitcnt vmcnt(0)" ::: "memory"); __syncthreads(); grid.sync(); \
        if (tid == 0) { __builtin_amdgcn_fence(__ATOMIC_ACQUIRE, "agent"); asm volatile("s_waitcnt vmcnt(0)" ::: "memory"); } __syncthreads(); } while (0)

    {
        LAS float* red = (LAS float*)lds;
        for (int task = bx; task < 72 * 32; task += G) {
            const int cgp = task % 72, ks = task / 72, k0 = ks * 64 + wave * 8;
            const float* wp = w_mod + (size_t)k0 * NMODW + cgp * 256 + lane * 4;
            f32x4 a0 = {0.f, 0.f, 0.f, 0.f}, a1 = {0.f, 0.f, 0.f, 0.f};
#pragma unroll
            for (int r = 0; r < 8; ++r) { const f32x4 w = *(const f32x4*)(wp + (size_t)r * NMODW);
                const float cv = cvec[k0 + r], cc = cctx[k0 + r];
                const float s0 = cv / (1.0f + __expf(-cv)), s1 = cc / (1.0f + __expf(-cc));
                a0 += w * s0; a1 += w * s1; }
            *(LAS f32x4*)(red + (wave * 64 + lane) * 8) = a0; *(LAS f32x4*)(red + (wave * 64 + lane) * 8 + 4) = a1;
            __syncthreads();
            { const int v = tid >> 8, col = tid & 255; float s = 0.f;
#pragma unroll
              for (int w = 0; w < 8; ++w) s += red[(w * 64 + (col >> 2)) * 8 + v * 4 + (col & 3)];
              atomicAdd(MOD + v * NMODW + cgp * 256 + col, s); }
            __syncthreads();
        }
        LAS float* scr = (LAS float*)(lds + wave * 16384);
        constexpr int I_FI = (DM / 64) * (2 * DFF / 32), I_FO = (DFF / 64) * (DM / 32), I_IN = (DM / 64) * (INW / 32), I_SQ = (DM / 64) * (DM / 32);
        constexpr int NITEMS = 2 * I_FI + 2 * I_FO + I_IN + 3 * I_SQ;
        for (int it = gw; it < NITEMS; it += NGW) {
            int r = it;
            if (r < I_FI) { transpose_item<1>(a.in[7], DM, 2 * DFF, W1T, scr, r, lane); continue; } r -= I_FI;
            if (r < I_FO) { transpose_item<0>(a.in[8], DFF, DM, W2T, scr, r, lane); continue; } r -= I_FO;
            if (r < I_IN) { transpose_item<0>(a.in[11], DM, INW, WINT, scr, r, lane); continue; } r -= I_IN;
            if (r < I_FI) { transpose_item<1>(a.in[9], DM, 2 * DFF, W3T, scr, r, lane); continue; } r -= I_FI;
            if (r < I_FO) { transpose_item<0>(a.in[10], DFF, DM, W4T, scr, r, lane); continue; } r -= I_FO;
            if (r < I_SQ) { transpose_item<0>(a.in[19], DM, DM, WBAT, scr, r, lane); continue; } r -= I_SQ;
            if (r < I_SQ) { transpose_item<0>(a.in[20], DM, DM, WBGT, scr, r, lane); continue; } r -= I_SQ;
            transpose_item<0>(a.in[21], DM, DM, WOT, scr, r, lane);
        }
        for (int idx = bx * NTHREADS + tid; idx < SEQ * 64; idx += G * NTHREADS) {
            const int t = idx >> 6, i = idx & 63, f = i & 31;
            const float pos = (float)(i < 32 ? (t >> 6) : (t & 63));
            const float inv = powf(10000.0f, -(float)(2 * f) / 64.0f);
            float sn, cs; sincosf(pos * inv, &sn, &cs);
            *(f32x2*)(ROPE + (size_t)t * 128 + 2 * i) = (f32x2){cs, sn};
        }
    }
    GRID_SYNC();

    if (DBG_DUMP == 90) DUMP_AND_RETURN(a.in[12][c] + a.in[12][2048 + c] + a.in[13][c & 127] + a.in[14][c & 127] + a.in[15][c] + a.in[16][c] + a.in[5][c] + a.in[6][c] + a.in[22][c] + a.in[18][c] + a.in[1][c] + a.in[3][c]);
    for (int m = gw; m < MTOT; m += NGW) {
        const int v = m < SEQ ? 0 : 1; const float* xr = m < SEQ ? x + (size_t)m * DM : ctx + (size_t)(m - SEQ) * DM;
        norm_mod_row(xr, norm_w, MOD + v * NMODW, b_mod, MOD + v * NMODW + DM, b_mod + DM, H + (size_t)m * DM, lane);
    }
    GRID_SYNC();

    if (DBG_DUMP == 1) DUMP_AND_RETURN(BFV(H, e_) + BFV(W1T, e_) + BFV(WINT, e_ + 4096u * 2048u) + MOD[e_ % 36864]);
    { pg8::Gemm g{H, W1T, MTOT, 2 * DFF, DM}; pg8::StaticOrder S; S.init(MTOT, 2 * DFF, G, bx);
      pg8::EpiSwiglu E{HID, DFF};
      pg8::gemm_phase<pg8::EpiSwiglu, pg8::StaticOrder, true, true>(lds, g, S, E); }
    GRID_SYNC();

    if (DBG_DUMP == 2) DUMP_AND_RETURN(BFV(HID, r * 5632 + c) + BFV(HID, r * 5632 + 2048 + c) + (r < 256 ? BFV(HID, (8192 + r) * 5632 + 3000 + c) : 0.f));
    { pg8::Gemm g{HID, W2T, MTOT, DM, DFF}; pg8::StaticOrder S; S.init(MTOT, DM, G, bx);
      pg8::EpiResid E{x, ctx, X1, MOD, b_mod, 2, 0.5f, SEQ};
      pg8::gemm_phase<pg8::EpiResid, pg8::StaticOrder, true, true>(lds, g, S, E); }
    GRID_SYNC();

#ifndef STOP_AFTER
#define STOP_AFTER 99
#endif
    if (STOP_AFTER >= 8) {
    for (int m = gw; m < MTOT; m += NGW) {
        const int v = m < SEQ ? 0 : 1;
        norm_mod_row(X1 + (size_t)m * DM, norm_w + DM, MOD + v * NMODW + 3 * DM, b_mod + 3 * DM, MOD + v * NMODW + 4 * DM, b_mod + 4 * DM, H + (size_t)m * DM, lane);
    }
    GRID_SYNC();

    { pg8::Gemm g{H, WINT, MTOT, INW, DM}; InProjOrder S; S.base.init(SEQ, INW, G, bx); S.nextra = 4;
      pg8::EpiInProj E{Qb, KA, VA, Ub, GVb, G0, G1, GVP, ROPE, a.in[13], a.in[14], a.in[12], (LAS float*)(lds + XS_OFF), SEQ};
      pg8::gemm_phase<pg8::EpiInProj, InProjOrder, true, true>(lds, g, S, E); }
    GRID_SYNC();

    if (DBG_DUMP == 5) DUMP_AND_RETURN(BFV(Qb, e_) + BFV(Ub, e_) + BFV(GVb, e_) + BFV(G0, e_) + BFV(G1, e_) + BFV(KA, r * 512 + (c & 511)) + BFV(VA, r * 512 + (c & 511)) + (c < 64 ? GVP[r * 64 + c] : 0.f) + (r < 256 ? BFV(KA, (8192 + r) * 512 + (c & 511)) + BFV(VA, (8192 + r) * 512 + (c & 511)) : 0.f));
    if (DBG_DUMP == 51) DUMP_AND_RETURN(BFV(Qb, e_));
    if (DBG_DUMP == 52) DUMP_AND_RETURN(BFV(KA, r * 512 + (c & 511)) + BFV(VA, r * 512 + (c & 511)) + (r < 256 ? BFV(KA, (8192 + r) * 512 + (c & 511)) + BFV(VA, (8192 + r) * 512 + (c & 511)) : 0.f));
    if (DBG_DUMP == 53) DUMP_AND_RETURN(BFV(Ub, e_) + BFV(GVb, e_) + (c < 64 ? GVP[r * 64 + c] : 0.f));
    if (DBG_DUMP == 54) DUMP_AND_RETURN(BFV(G0, e_) + BFV(G1, e_));
    if (DBG_DUMP == 55) DUMP_AND_RETURN(BFV(H, e_) + (r < 256 ? BFV(H, (8192 + r) * 2048 + c) : 0.f));
    for (int uidx = vcu; uidx < 512; uidx += G) {
        const int h = uidx >> 5, qb = uidx & 31, kvh = h >> 2;
        att::attn_dense_body<att::bf16>((const att::bf16*)Qb + (size_t)qb * 256 * DM + h * 128, (const att::bf16*)KA + kvh * 128, (const att::bf16*)VA + kvh * 128,
                                        (att::bf16*)ATT + (size_t)qb * 256 * DM + h * 128, MTOT, (char*)lds_raw);
        __syncthreads();
    }
    for (int uidx = vcu; uidx < 1024; uidx += G)
        spatial_unit(lds, uidx >> 4, uidx & 15, GVb, GVP, Ub, Ub, w_spatial, b_spatial, a.in[15], a.in[16], tid, lane, wave);
    GRID_SYNC();

    if (DBG_DUMP == 6) DUMP_AND_RETURN(BFV(ATT, e_) + BFV(Ub, e_));
    if (DBG_DUMP == 61) DUMP_AND_RETURN(BFV(ATT, e_));
    if (DBG_DUMP == 62) DUMP_AND_RETURN(BFV(Ub, e_));
    { pg8::Gemm g{ATT, WBAT, SEQ, DM, DM}; pg8::StaticOrder S; S.init(SEQ, DM, G, bx);
      pg8::EpiGate<false> E{G0, nullptr, T1};
      pg8::gemm_phase<pg8::EpiGate<false>, pg8::StaticOrder, true, true>(lds, g, S, E); }
    GRID_SYNC();
    { pg8::Gemm g{Ub, WBGT, SEQ, DM, DM}; pg8::StaticOrder S; S.init(SEQ, DM, G, bx);
      pg8::EpiGate<true> E{G1, T1, MRG};
      pg8::gemm_phase<pg8::EpiGate<true>, pg8::StaticOrder, true, true>(lds, g, S, E); }
    GRID_SYNC();
    if (DBG_DUMP == 7) DUMP_AND_RETURN(BFV(MRG, e_));
    { pg8::Gemm g{MRG, WOT, SEQ, DM, DM}; pg8::StaticOrder S; S.init(SEQ, DM, G, bx);
      pg8::EpiResid E{X1, X1, X1, MOD, b_mod, 5, 1.0f, SEQ};
      pg8::gemm_phase<pg8::EpiResid, pg8::StaticOrder, true, true>(lds, g, S, E); }
    GRID_SYNC();
    }
    if (STOP_AFTER >= 11) {
    for (int m = gw; m < SEQ; m += NGW)
        norm_mod_row(X1 + (size_t)m * DM, norm_w + 2 * DM, MOD + 6 * DM, b_mod + 6 * DM, MOD + 7 * DM, b_mod + 7 * DM, H + (size_t)m * DM, lane);
    GRID_SYNC();
    { pg8::Gemm g{H, W3T, SEQ, 2 * DFF, DM}; pg8::StaticOrder S; S.init(SEQ, 2 * DFF, G, bx);
      pg8::EpiSwiglu E{HID, DFF};
      pg8::gemm_phase<pg8::EpiSwiglu, pg8::StaticOrder, true, true>(lds, g, S, E); }
    GRID_SYNC();
    { pg8::Gemm g{HID, W4T, SEQ, DM, DFF}; pg8::StaticOrder S; S.init(SEQ, DM, G, bx);
      pg8::EpiResid E{X1, X1, X1, MOD, b_mod, 8, 0.5f, SEQ};
      pg8::gemm_phase<pg8::EpiResid, pg8::StaticOrder, true, true>(lds, g, S, E); }
    GRID_SYNC();
    }
    if (DBG_DUMP == 91) DUMP_AND_RETURN(a.in[12][c] + a.in[12][2048 + c] + a.in[13][c & 127] + a.in[14][c & 127] + a.in[15][c] + a.in[16][c] + a.in[5][c] + a.in[6][c] + a.in[22][c] + a.in[18][c] + a.in[1][c] + a.in[3][c]);
    for (int m = gw; m < SEQ; m += NGW) {
        const f32x4* xr = (const f32x4*)(X1 + (size_t)m * DM) + lane; const f32x4* fw = (const f32x4*)a.in[22] + lane;
        f32x4 v[8]; float ss = 0.f;
#pragma unroll
        for (int j = 0; j < 8; ++j) { v[j] = xr[64 * j]; ss += (v[j][0] * v[j][0] + v[j][1] * v[j][1]) + (v[j][2] * v[j][2] + v[j][3] * v[j][3]); }
        const float rinv = 1.0f / sqrtf(wave_sum(ss) * (1.0f / DM) + EPS);
        f32x4* o = (f32x4*)(a.out + (size_t)m * DM) + lane;
#pragma unroll
        for (int j = 0; j < 8; ++j) o[64 * j] = v[j] * rinv * fw[64 * j];
    }
}

extern "C" void kernel_launch(void* const* d_in, const int* in_sizes, int n_in, void* d_out, int out_size, void* d_ws, size_t ws_size, hipStream_t stream) {
    static int grid = 0;
    if (grid == 0) {
        if (n_in != 23 || in_sizes[0] != SEQ * DM || out_size != SEQ * DM || ws_size < WS_END) {
            fprintf(stderr, "kernel_launch: shape mismatch: n_in %d in0 %d out %d ws %zu (need %zu)\n", n_in, n_in > 0 ? in_sizes[0] : -1, out_size, ws_size, (size_t)WS_END); grid = -1; return; }
        int dev = 0, cus = 0, per_cu = 0;
        if (hipGetDevice(&dev) != hipSuccess || hipDeviceGetAttribute(&cus, hipDeviceAttributeMultiprocessorCount, dev) != hipSuccess) { fprintf(stderr, "kernel_launch: device query failed\n"); grid = -1; return; }
        if (hipFuncSetAttribute((const void*)fwd_kernel, hipFuncAttributeMaxDynamicSharedMemorySize, LDS_BYTES) != hipSuccess) { fprintf(stderr, "kernel_launch: hipFuncSetAttribute failed\n"); grid = -1; return; }
        if (hipOccupancyMaxActiveBlocksPerMultiprocessor(&per_cu, (const void*)fwd_kernel, NTHREADS, LDS_BYTES) != hipSuccess || per_cu < 1) { fprintf(stderr, "kernel_launch: occupancy query says %d blocks per CU\n", per_cu); (void)hipGetLastError(); grid = -1; return; }
        grid = cus * 1;
    }
    if (grid < 0) return;
    (void)hipMemsetAsync((char*)d_ws + WS_CTL, 0, CTL_ZERO_BYTES, stream);
    Args a{};
    for (int i = 0; i < 23; ++i) a.in[i] = (const float*)d_in[i];
    a.out = (float*)d_out; a.ws = (unsigned char*)d_ws;
    void* args[] = {&a};
    const hipError_t e = hipLaunchCooperativeKernel((const void*)fwd_kernel, dim3(grid), dim3(NTHREADS), args, LDS_BYTES, stream);
    if (e != hipSuccess) fprintf(stderr, "kernel_launch: cooperative launch failed: %s (grid %d)\n", hipGetErrorString(e), grid);
}
```

```cpp
#include <hip/hip_runtime.h>
#include <hip/hip_cooperative_groups.h>
#include <hip/hip_bf16.h>
#include <cstdio>
#include <cstdint>
#include <cmath>
namespace pg8 {
#define PG8_LAS __attribute__((address_space(3)))
typedef unsigned short bf16_t;
typedef short bf16x8 __attribute__((ext_vector_type(8)));
typedef float f32x4 __attribute__((ext_vector_type(4)));
typedef unsigned u32x4 __attribute__((ext_vector_type(4)));
constexpr int BM = 256, BK = 64, HALF = 128, HTB = HALF * BK * 2  , STAGE_BYTES = 8 * HTB, NXCD = 8, WGM = 8;

__host__ __device__ __forceinline__ int lds_byte(int r, int c) { const int st = (r >> 4) * 2 + (c >> 5), rr = r & 15, cc = c & 31, ob = rr * 64 + cc * 2; return st * 1024 + (ob ^ (((ob >> 9) & 1) << 5)); }
__host__ __device__ __forceinline__ void stage_rc(int b, int& R, int& C) { const int st = b / 1024, sb = b % 1024, swz = sb ^ (((sb >> 9) & 1) << 5); R = (st >> 1) * 16 + swz / 64; C = (st & 1) * 32 + (swz % 64) / 2; }
__host__ __device__ __forceinline__ int perm32(int rho) { const int n = rho >> 4, i = rho & 15; return 8 * (i >> 2) + 4 * n + (i & 3); }

struct Unit { int pm, pn; int kt0 = 0, nkt = 0; };
struct Gemm { const bf16_t* A; const bf16_t* Bt; int M, N, K; };

struct StaticOrder {
    int nM, nN, nwg, G, c;
    __host__ __device__ void init(int M, int N, int G_, int c_) { nM = M / BM; nN = N / BM; nwg = nM * nN; G = G_; c = c_; }
    __host__ __device__ bool next(int i, Unit& u) const {
        const long L = (long)i * G + c; if (L >= nwg) return false;
        int wgid = (int)L; { const int q = nwg / NXCD, r = nwg % NXCD, xcd = wgid % NXCD, off = wgid / NXCD; wgid = (xcd < r ? xcd * (q + 1) : r * (q + 1) + (xcd - r) * q) + off; }
        const int nig = WGM * nN, gid = wgid / nig, fm = gid * WGM, gsz = (nM - fm) < WGM ? (nM - fm) : WGM;
        u.pm = fm + ((wgid % nig) % gsz); u.pn = (wgid % nig) / gsz; return true;
    }
    __device__ __forceinline__ void a_ready(const Unit&) const {}
    __device__ __forceinline__ void done(const Unit&) const {}
};

typedef float f32x2c_t __attribute__((ext_vector_type(2))); typedef __bf16 bf16x2c_t __attribute__((ext_vector_type(2)));
__device__ __forceinline__ unsigned cvt_pk_bf16(float lo, float hi) { f32x2c_t v = {lo, hi}; bf16x2c_t b = __builtin_convertvector(v, bf16x2c_t); return __builtin_bit_cast(unsigned, b); }
typedef float f32x2 __attribute__((ext_vector_type(2)));
__device__ __forceinline__ f32x2 gelu_pk(f32x2 v) {
    const f32x2 av = __builtin_elementwise_abs(v), d = av * 0.2316418882f + 1.0f;
    f32x2 t; t.x = __builtin_amdgcn_rcpf(d.x); t.y = __builtin_amdgcn_rcpf(d.y);
    f32x2 q = t * 0.5307027145f + (-0.7265760135f); q = q * t + 0.7107068705f; q = q * t + (-0.142248368f); q = q * t + 0.127414796f; q = q * t;
    const f32x2 s = (v * v) * (-0.72134752044f);
    f32x2 e; e.x = __builtin_amdgcn_exp2f(s.x); e.y = __builtin_amdgcn_exp2f(s.y);
    const f32x2 m = v * (q * e), r = v - m;
    f32x2 o; o.x = v.x < 0.f ? m.x : r.x; o.y = v.y < 0.f ? m.y : r.y; return o;
}


typedef unsigned u32x2 __attribute__((ext_vector_type(2)));
__device__ __forceinline__ float bf_lo(unsigned w) { return __uint_as_float(w << 16); }
__device__ __forceinline__ float bf_hi(unsigned w) { return __uint_as_float(w & 0xffff0000u); }
__device__ __forceinline__ float fast_sigmoid(float x) { return __builtin_amdgcn_rcpf(1.0f + __builtin_amdgcn_exp2f(-1.4426950408889634f * x)); }
__device__ __forceinline__ float fast_silu(float x) { return x * fast_sigmoid(x); }
__device__ __forceinline__ u32x4 pack8(const f32x4 v0, const f32x4 v1) { u32x4 w; w.x = cvt_pk_bf16(v0[0], v0[1]); w.y = cvt_pk_bf16(v0[2], v0[3]); w.z = cvt_pk_bf16(v1[0], v1[1]); w.w = cvt_pk_bf16(v1[2], v1[3]); return w; }

struct EpiSwiglu {
    static constexpr bool PERM = true, AFTER_DRAIN = false;
    bf16_t* O; int ldc;
    __device__ __forceinline__ void operator()(const f32x4 (&acc)[2][2][4][2], const Unit& u, int wr, int wc, int fr, int fq) const {
        const int row0 = u.pm * BM + wr * 64 + fr, col0 = u.pn * HALF + wc * 32 + 8 * fq;
#pragma unroll
        for (int ai = 0; ai < 2; ++ai)
#pragma unroll
            for (int m = 0; m < 4; ++m) {
                bf16_t* rowp = O + (size_t)(row0 + ai * HALF + m * 16) * ldc + col0;
                f32x4 h0, h1;
#pragma unroll
                for (int j = 0; j < 4; ++j) { h0[j] = fast_silu(acc[ai][0][m][0][j]) * acc[ai][1][m][0][j]; h1[j] = fast_silu(acc[ai][0][m][1][j]) * acc[ai][1][m][1][j]; }
                *(u32x4*)rowp = pack8(h0, h1);
            }
    }
};

struct EpiResid {
    static constexpr bool PERM = false, AFTER_DRAIN = false;
    const float* src; const float* src2; float* out; const float* mod; const float* bmod; int gate_idx; float coef; int seq_rows;
    __device__ __forceinline__ void operator()(const f32x4 (&acc)[2][2][4][2], const Unit& u, int wr, int wc, int fr, int fq) const {
        const int col0 = u.pn * BM + wc * 32 + 4 * fq;
        const int v = (u.pm * BM >= seq_rows) ? 1 : 0;
        f32x4 g[2][2];
#pragma unroll
        for (int bj = 0; bj < 2; ++bj)
#pragma unroll
            for (int n = 0; n < 2; ++n) { const int c = gate_idx * 2048 + col0 + bj * HALF + n * 16;
                g[bj][n] = (*(const f32x4*)(mod + v * 18432 + c) + *(const f32x4*)(bmod + c)) * coef; }
#pragma unroll
        for (int ai = 0; ai < 2; ++ai)
#pragma unroll
            for (int m = 0; m < 4; ++m) { const int r = u.pm * BM + ai * HALF + wr * 64 + m * 16 + fr;
                const float* s = (r < seq_rows) ? src + (size_t)r * 2048 : src2 + (size_t)(r - seq_rows) * 2048;
                float* o = out + (size_t)r * 2048;
#pragma unroll
                for (int bj = 0; bj < 2; ++bj)
#pragma unroll
                    for (int n = 0; n < 2; ++n) { const int c = col0 + bj * HALF + n * 16;
                        *(f32x4*)(o + c) = *(const f32x4*)(s + c) + g[bj][n] * acc[ai][bj][m][n]; } }
    }
};

struct EpiResidSplit {
    static constexpr bool PERM = false, AFTER_DRAIN = false;
    const float* src; const float* src2; float* out; const float* mod; const float* bmod; float* slab;
    static constexpr int gate_idx = 2, seq_rows = 8192; static constexpr float coef = 0.5f;
    __device__ __forceinline__ void operator()(const f32x4 (&acc)[2][2][4][2], const Unit& u, int wr, int wc, int fr, int fq) const {
        const int col0 = u.pn * BM + wc * 32 + 4 * fq;
        if (u.nkt != 0) {
            float* sb = slab + (size_t)(u.kt0 >> 3) * 256 * 2048 + col0;
#pragma unroll
            for (int ai = 0; ai < 2; ++ai)
#pragma unroll
                for (int m = 0; m < 4; ++m) { float* o = sb + (size_t)(ai * HALF + wr * 64 + m * 16 + fr) * 2048;
#pragma unroll
                    for (int bj = 0; bj < 2; ++bj)
#pragma unroll
                        for (int n = 0; n < 2; ++n) *(f32x4*)(o + bj * HALF + n * 16) = acc[ai][bj][m][n]; }
        } else {
        const int v = (u.pm * BM >= seq_rows) ? 1 : 0;
        f32x4 g[2][2];
#pragma unroll
        for (int bj = 0; bj < 2; ++bj)
#pragma unroll
            for (int n = 0; n < 2; ++n) { const int c = gate_idx * 2048 + col0 + bj * HALF + n * 16;
                g[bj][n] = (*(const f32x4*)(mod + v * 18432 + c) + *(const f32x4*)(bmod + c)) * coef; }
#pragma unroll
        for (int ai = 0; ai < 2; ++ai)
#pragma unroll
            for (int m = 0; m < 4; ++m) { const int r = u.pm * BM + ai * HALF + wr * 64 + m * 16 + fr;
                const float* s = (r < seq_rows) ? src + (size_t)r * 2048 : src2 + (size_t)(r - seq_rows) * 2048;
                float* o = out + (size_t)r * 2048;
#pragma unroll
                for (int bj = 0; bj < 2; ++bj)
#pragma unroll
                    for (int n = 0; n < 2; ++n) { const int c = col0 + bj * HALF + n * 16;
                        *(f32x4*)(o + c) = *(const f32x4*)(s + c) + g[bj][n] * acc[ai][bj][m][n]; } }
        }
    }
};

template <bool ADD> struct EpiGate {
    static constexpr bool PERM = true, AFTER_DRAIN = false;
    const bf16_t* G; const bf16_t* T; bf16_t* O;
    __device__ __forceinline__ void operator()(const f32x4 (&acc)[2][2][4][2], const Unit& u, int wr, int wc, int fr, int fq) const {
        const int row0 = u.pm * BM + wr * 64 + fr, col0 = u.pn * BM + wc * 32 + 8 * fq;
#pragma unroll
        for (int ai = 0; ai < 2; ++ai)
#pragma unroll
            for (int m = 0; m < 4; ++m)
#pragma unroll
                for (int bj = 0; bj < 2; ++bj) { const size_t off = (size_t)(row0 + ai * HALF + m * 16) * 2048 + col0 + bj * HALF;
                    const u32x4 gw = *(const u32x4*)(G + off);
                    f32x4 v0 = acc[ai][bj][m][0], v1 = acc[ai][bj][m][1];
                    v0[0] *= bf_lo(gw.x); v0[1] *= bf_hi(gw.x); v0[2] *= bf_lo(gw.y); v0[3] *= bf_hi(gw.y);
                    v1[0] *= bf_lo(gw.z); v1[1] *= bf_hi(gw.z); v1[2] *= bf_lo(gw.w); v1[3] *= bf_hi(gw.w);
                    if (ADD) { const u32x4 tw = *(const u32x4*)(T + off);
                        v0[0] += bf_lo(tw.x); v0[1] += bf_hi(tw.x); v0[2] += bf_lo(tw.y); v0[3] += bf_hi(tw.y);
                        v1[0] += bf_lo(tw.z); v1[1] += bf_hi(tw.z); v1[2] += bf_lo(tw.w); v1[3] += bf_hi(tw.w); }
                    *(u32x4*)(O + off) = pack8(v0, v1); }
    }
};

struct EpiInProj {
    static constexpr bool PERM = true, AFTER_DRAIN = false;
    bf16_t *Q, *KA, *VA, *U, *GV, *G0, *G1; float* GVP; const float* rope; const float* qg; const float* kg; const float* bgate; PG8_LAS float* xs; int seq_rows;
    __device__ __forceinline__ void operator()(const f32x4 (&acc)[2][2][4][2], const Unit& u, int wr, int wc, int fr, int fq) const {
        const int pn = u.pn;
        const int row0 = u.pm * BM + wr * 64 + fr, cw = wc * 32 + 8 * fq;
        if (pn < 10) {
#pragma unroll
            for (int ai = 0; ai < 2; ++ai)
#pragma unroll
                for (int m = 0; m < 4; ++m)
#pragma unroll
                    for (int bj = 0; bj < 2; ++bj) { const f32x4 a = acc[ai][bj][m][0], b = acc[ai][bj][m][1];
                        float s = (a[0] * a[0] + a[1] * a[1]) + (a[2] * a[2] + a[3] * a[3]) + (b[0] * b[0] + b[1] * b[1]) + (b[2] * b[2] + b[3] * b[3]);
                        s += __shfl_xor(s, 16); s += __shfl_xor(s, 32);
                        if (fq == 0) xs[((bj * 256) + ai * HALF + wr * 64 + m * 16 + fr) * 4 + wc] = s; }
            asm volatile("s_waitcnt lgkmcnt(0)" ::: "memory"); __builtin_amdgcn_s_barrier(); asm volatile("" ::: "memory");
            const bool isq = pn < 8; const float* gain = isq ? qg : kg;
            const f32x4 g0 = *(const f32x4*)(gain + cw), g1 = *(const f32x4*)(gain + cw + 4);
#pragma unroll
            for (int ai = 0; ai < 2; ++ai)
#pragma unroll
                for (int m = 0; m < 4; ++m) { const int r = row0 + ai * HALF + m * 16;
                    const bool dorope = r < seq_rows;
                    f32x4 cs0 = {1.f, 0.f, 1.f, 0.f}, cs1 = {1.f, 0.f, 1.f, 0.f};
                    if (dorope) { const float* rp = rope + (size_t)r * 128 + cw; cs0 = *(const f32x4*)rp; cs1 = *(const f32x4*)(rp + 4); }
#pragma unroll
                    for (int bj = 0; bj < 2; ++bj) {
                        const f32x4 p = *(const PG8_LAS f32x4*)(xs + ((bj * 256) + ai * HALF + wr * 64 + m * 16 + fr) * 4);
                        const float rinv = __builtin_amdgcn_rsqf(((p[0] + p[1]) + (p[2] + p[3])) * (1.0f / 128.0f) + 1e-6f);
                        f32x4 a = acc[ai][bj][m][0] * rinv * g0, b = acc[ai][bj][m][1] * rinv * g1, ra, rb;
                        ra[0] = a[0] * cs0[0] - a[1] * cs0[1]; ra[1] = a[0] * cs0[1] + a[1] * cs0[0];
                        ra[2] = a[2] * cs0[2] - a[3] * cs0[3]; ra[3] = a[2] * cs0[3] + a[3] * cs0[2];
                        rb[0] = b[0] * cs1[0] - b[1] * cs1[1]; rb[1] = b[0] * cs1[1] + b[1] * cs1[0];
                        rb[2] = b[2] * cs1[2] - b[3] * cs1[3]; rb[3] = b[2] * cs1[3] + b[3] * cs1[2];
                        bf16_t* dst = isq ? Q + (size_t)r * 2048 + (2 * pn + bj) * 128 + cw : KA + (size_t)r * 512 + (2 * (pn - 8) + bj) * 128 + cw;
                        *(u32x4*)dst = pack8(ra, rb); } }
            asm volatile("s_waitcnt lgkmcnt(0)" ::: "memory"); __builtin_amdgcn_s_barrier(); asm volatile("" ::: "memory");
        } else if (pn < 12) {
#pragma unroll
            for (int ai = 0; ai < 2; ++ai)
#pragma unroll
                for (int m = 0; m < 4; ++m)
#pragma unroll
                    for (int bj = 0; bj < 2; ++bj)
                        *(u32x4*)(VA + (size_t)(row0 + ai * HALF + m * 16) * 512 + (2 * (pn - 10) + bj) * 128 + cw) = pack8(acc[ai][bj][m][0], acc[ai][bj][m][1]);
        } else if (pn < 28) {
            const bool isv = pn >= 20; bf16_t* dstb = isv ? GV : U; const int ct = (isv ? pn - 20 : pn - 12) * BM;
#pragma unroll
            for (int ai = 0; ai < 2; ++ai)
#pragma unroll
                for (int m = 0; m < 4; ++m) { const int r = row0 + ai * HALF + m * 16; float s1 = 0.f, s2 = 0.f;
#pragma unroll
                    for (int bj = 0; bj < 2; ++bj) { const f32x4 v0 = acc[ai][bj][m][0], v1 = acc[ai][bj][m][1];
                        const f32x2 a = gelu_pk((f32x2){v0[0], v0[1]}), b = gelu_pk((f32x2){v0[2], v0[3]}), c = gelu_pk((f32x2){v1[0], v1[1]}), d = gelu_pk((f32x2){v1[2], v1[3]});
                        s1 += ((a.x + a.y) + (b.x + b.y)) + ((c.x + c.y) + (d.x + d.y));
                        s2 += ((a.x * a.x + a.y * a.y) + (b.x * b.x + b.y * b.y)) + ((c.x * c.x + c.y * c.y) + (d.x * d.x + d.y * d.y));
                        *(u32x4*)(dstb + (size_t)r * 2048 + ct + bj * HALF + cw) = pack8((f32x4){a.x, a.y, b.x, b.y}, (f32x4){c.x, c.y, d.x, d.y}); }
                    if (isv) { s1 += __shfl_xor(s1, 16); s1 += __shfl_xor(s1, 32); s2 += __shfl_xor(s2, 16); s2 += __shfl_xor(s2, 32);
                        if (fq == 0) *(f32x2*)(GVP + ((size_t)r * 32 + (pn - 20) * 4 + wc) * 2) = (f32x2){s1, s2}; } }
        } else {
            const int gi = pn >= 36 ? 1 : 0; bf16_t* dstb = gi ? G1 : G0; const int ct = (pn - 28 - 8 * gi) * BM;
#pragma unroll
            for (int bj = 0; bj < 2; ++bj) { const f32x4 b0 = *(const f32x4*)(bgate + gi * 2048 + ct + bj * HALF + cw), b1 = *(const f32x4*)(bgate + gi * 2048 + ct + bj * HALF + cw + 4);
#pragma unroll
                for (int ai = 0; ai < 2; ++ai)
#pragma unroll
                    for (int m = 0; m < 4; ++m) { f32x4 v0 = acc[ai][bj][m][0] + b0, v1 = acc[ai][bj][m][1] + b1;
#pragma unroll
                        for (int j = 0; j < 4; ++j) { v0[j] = fast_sigmoid(v0[j]); v1[j] = fast_sigmoid(v1[j]); }
                        *(u32x4*)(dstb + (size_t)(row0 + ai * HALF + m * 16) * 2048 + ct + bj * HALF + cw) = pack8(v0, v1); } }
        }
    }
};
template <class Epi, class Sched, bool ALIGN_EPI = false, bool SP2 = false>
__device__ __forceinline__ void gemm_phase(PG8_LAS unsigned char* lds, const Gemm g, const Sched S, const Epi E) {
    int tid_ = threadIdx.x; asm volatile("" : "+v"(tid_));
    const int tid = tid_, wid = __builtin_amdgcn_readfirstlane(tid >> 6), lane = tid & 63, wr = wid >> 2, wc = wid & 3, fr = lane & 15, fq = lane >> 4;
    const int K = g.K, nt_full = K / BK;
    unsigned voffA[2], voffB[2];
#pragma unroll
    for (int i = 0; i < 2; ++i) { int R, C; stage_rc(tid * 16 + i * 8192, R, C); const int Rb = Epi::PERM ? ((R & ~31) + perm32(R & 31)) : R;
        voffA[i] = (unsigned)(R * K + C) * 2u; voffB[i] = (unsigned)(Rb * K + C) * 2u; }
    const size_t kstep = (size_t)(BK * 2);
    const size_t hstep = (size_t)HALF * K * 2;
    const size_t tstep = 2 * hstep;
    const unsigned ldsw = (unsigned)wid * 1024u;
    const int aoff = lds_byte(wr * 64 + fr, fq * 8), boff = lds_byte(wc * 32 + fr, fq * 8);
#define PG8_SA(b, h) (((b) * 2 + (h)) * HTB)
#define PG8_SB(b, h) ((4 + (b) * 2 + (h)) * HTB)
#define PG8_STAGE(bufoff, gbase, voff) do { _Pragma("unroll") for (int _i = 0; _i < 2; ++_i) \
        __builtin_amdgcn_global_load_lds((const unsigned*)((const char*)(gbase) + (voff)[_i]), (PG8_LAS unsigned*)(lds + (bufoff) + ldsw + _i * 8192), 16, 0, 0); } while (0)
#define PG8_LDA(dst, b, h) do { _Pragma("unroll") for (int m = 0; m < 4; ++m) _Pragma("unroll") for (int k = 0; k < 2; ++k) dst[m][k] = *(const PG8_LAS bf16x8*)(lds + PG8_SA(b, h) + aoff + m * 2048 + k * 1024); } while (0)
#define PG8_LDB(dst, b, h) do { _Pragma("unroll") for (int n = 0; n < 2; ++n) _Pragma("unroll") for (int k = 0; k < 2; ++k) dst[n][k] = *(const PG8_LAS bf16x8*)(lds + PG8_SB(b, h) + boff + n * 2048 + k * 1024); } while (0)
#define PG8_MMA(ai, bj, At, Bt) do { __builtin_amdgcn_s_setprio(1); _Pragma("unroll") for (int m = 0; m < 4; ++m) _Pragma("unroll") for (int n = 0; n < 2; ++n) _Pragma("unroll") for (int k = 0; k < 2; ++k) \
        acc[ai][bj][m][n] = __builtin_amdgcn_mfma_f32_16x16x32_bf16(Bt[n][k], At[m][k], acc[ai][bj][m][n], 0, 0, 0); __builtin_amdgcn_s_setprio(0); } while (0)
#define PG8_WAIT_V(n) asm volatile("s_waitcnt vmcnt(" #n ")" ::: "memory")
#define PG8_WAIT_L(n) asm volatile("s_waitcnt lgkmcnt(" #n ")" ::: "memory")
#define PG8_BAR __builtin_amdgcn_s_barrier()
#define PG8_SCHED __builtin_amdgcn_sched_barrier(0)
    Unit cur, nxt; int ui = 0;
    if (!S.next(0, cur)) return;
    f32x4 acc[2][2][4][2];
#pragma unroll
    for (int a = 0; a < 2; ++a)
#pragma unroll
        for (int b = 0; b < 2; ++b)
#pragma unroll
            for (int m = 0; m < 4; ++m)
#pragma unroll
                for (int n = 0; n < 2; ++n) acc[a][b][m][n] = (f32x4){0.f, 0.f, 0.f, 0.f};
    bf16x8 At[4][2], B0[2][2], B1[2][2];
    const char* cA = (const char*)g.A + (size_t)cur.pm * tstep + (size_t)cur.kt0 * kstep; const char* cB = (const char*)g.Bt + (size_t)cur.pn * tstep + (size_t)cur.kt0 * kstep;
    S.a_ready(cur);
    if constexpr (SP2) {
        PG8_STAGE(PG8_SB(0, 0), cB, voffB); PG8_STAGE(PG8_SB(0, 1), cB + hstep, voffB); PG8_STAGE(PG8_SA(0, 0), cA, voffA); PG8_STAGE(PG8_SA(0, 1), cA + hstep, voffA);
        if (wr == 1) PG8_BAR;
        PG8_WAIT_V(2); PG8_BAR;
        PG8_STAGE(PG8_SB(1, 0), cB + kstep, voffB); PG8_STAGE(PG8_SA(1, 0), cA + kstep, voffA); PG8_STAGE(PG8_SB(1, 1), cB + hstep + kstep, voffB);
        PG8_WAIT_V(6); PG8_BAR;
    } else {
        PG8_STAGE(PG8_SB(0, 0), cB, voffB); PG8_STAGE(PG8_SA(0, 0), cA, voffA); PG8_STAGE(PG8_SB(0, 1), cB + hstep, voffB); PG8_STAGE(PG8_SA(0, 1), cA + hstep, voffA);
        if (wr == 1) PG8_BAR;
        PG8_WAIT_V(4); PG8_BAR;
        PG8_STAGE(PG8_SB(1, 0), cB + kstep, voffB); PG8_STAGE(PG8_SA(1, 0), cA + kstep, voffA); PG8_STAGE(PG8_SB(1, 1), cB + hstep + kstep, voffB);
        PG8_WAIT_V(6); PG8_BAR;
    }
    for (;;) {
        const bool has_next = S.next(ui + 1, nxt);
        const char* nA = has_next ? (const char*)g.A + (size_t)nxt.pm * tstep + (size_t)nxt.kt0 * kstep : cA; const char* nB = has_next ? (const char*)g.Bt + (size_t)nxt.pn * tstep + (size_t)nxt.kt0 * kstep : cB;
        const int nt = cur.nkt ? cur.nkt : nt_full;
        for (int t = 0; t < nt; t += 2) {
            const bool last = (t == nt - 2);
            const char* a1 = cA + (size_t)(t + 1) * kstep;
            const char* a2 = last ? nA : cA + (size_t)(t + 2) * kstep; const char* b2 = last ? nB : cB + (size_t)(t + 2) * kstep;
            const char* a3 = a2 + kstep; const char* b3 = b2 + kstep;
            if (last && has_next) S.a_ready(nxt);
            if constexpr (SP2) {
            PG8_LDB(B0, 0, 0); PG8_LDB(B1, 0, 1); PG8_SCHED; PG8_LDA(At, 0, 0); PG8_STAGE(PG8_SA(1, 1), a1 + hstep, voffA);
            PG8_WAIT_V(8); PG8_WAIT_L(0); PG8_BAR; PG8_MMA(0, 0, At, B0); PG8_MMA(0, 1, At, B1); PG8_BAR; PG8_SCHED;
            PG8_LDA(At, 0, 1); PG8_STAGE(PG8_SB(0, 0), b2, voffB); PG8_STAGE(PG8_SB(0, 1), b2 + hstep, voffB); PG8_STAGE(PG8_SA(0, 0), a2, voffA);
            PG8_WAIT_V(8); PG8_WAIT_L(0); PG8_BAR; PG8_MMA(1, 0, At, B0); PG8_MMA(1, 1, At, B1); PG8_BAR; PG8_SCHED;
            PG8_LDB(B0, 1, 0); PG8_LDB(B1, 1, 1); PG8_SCHED; PG8_LDA(At, 1, 0); PG8_STAGE(PG8_SA(0, 1), a2 + hstep, voffA);
            PG8_WAIT_V(8); PG8_WAIT_L(0); PG8_BAR; PG8_MMA(0, 0, At, B0); PG8_MMA(0, 1, At, B1); PG8_BAR; PG8_SCHED;
            PG8_LDA(At, 1, 1); PG8_STAGE(PG8_SB(1, 0), b3, voffB); PG8_STAGE(PG8_SB(1, 1), b3 + hstep, voffB); PG8_STAGE(PG8_SA(1, 0), a3, voffA);
            PG8_WAIT_V(8); PG8_WAIT_L(0); PG8_BAR; PG8_MMA(1, 0, At, B0); PG8_MMA(1, 1, At, B1); PG8_BAR; PG8_SCHED;
            } else {
            PG8_LDB(B0, 0, 0); PG8_SCHED; PG8_LDA(At, 0, 0); PG8_STAGE(PG8_SA(1, 1), a1 + hstep, voffA);
            PG8_WAIT_L(8); PG8_BAR; PG8_WAIT_L(0); PG8_MMA(0, 0, At, B0); PG8_BAR; PG8_SCHED;
            PG8_LDB(B1, 0, 1); PG8_STAGE(PG8_SB(0, 0), b2, voffB);
            PG8_BAR; PG8_WAIT_L(0); PG8_MMA(0, 1, At, B1); PG8_BAR;
            PG8_LDA(At, 0, 1); PG8_STAGE(PG8_SA(0, 0), a2, voffA);
            PG8_BAR; PG8_WAIT_L(0); PG8_MMA(1, 0, At, B0); PG8_BAR; PG8_SCHED;
            PG8_STAGE(PG8_SB(0, 1), b2 + hstep, voffB);
            PG8_WAIT_V(6); PG8_BAR; PG8_MMA(1, 1, At, B1); PG8_BAR;
            PG8_LDB(B0, 1, 0); PG8_SCHED; PG8_LDA(At, 1, 0); PG8_STAGE(PG8_SA(0, 1), a2 + hstep, voffA);
            PG8_WAIT_L(8); PG8_BAR; PG8_WAIT_L(0); PG8_MMA(0, 0, At, B0); PG8_BAR; PG8_SCHED;
            PG8_LDB(B1, 1, 1); PG8_STAGE(PG8_SB(1, 0), b3, voffB);
            PG8_BAR; PG8_WAIT_L(0); PG8_MMA(0, 1, At, B1); PG8_BAR;
            PG8_LDA(At, 1, 1); PG8_STAGE(PG8_SA(1, 0), a3, voffA);
            PG8_BAR; PG8_WAIT_L(0); PG8_MMA(1, 0, At, B0); PG8_BAR; PG8_SCHED;
            PG8_STAGE(PG8_SB(1, 1), b3 + hstep, voffB);
            PG8_WAIT_V(6); PG8_BAR; PG8_MMA(1, 1, At, B1); PG8_BAR;
            }
        }
        if constexpr (ALIGN_EPI) { if (wr == 0) PG8_BAR; }
        if constexpr (!Epi::AFTER_DRAIN) { E(acc, cur, wr, wc, fr, fq); S.done(cur); }
        if (!has_next) break;
#pragma unroll
        for (int a = 0; a < 2; ++a)
#pragma unroll
            for (int b = 0; b < 2; ++b)
#pragma unroll
                for (int m = 0; m < 4; ++m)
#pragma unroll
                    for (int n = 0; n < 2; ++n) acc[a][b][m][n] = (f32x4){0.f, 0.f, 0.f, 0.f};
        cur = nxt; cA = nA; cB = nB; ++ui;
        if constexpr (ALIGN_EPI) { if (wr == 1) PG8_BAR; }
    }
    PG8_WAIT_V(0);
    if constexpr (!ALIGN_EPI) { if (wr == 0) PG8_BAR; }
    PG8_BAR;
    if constexpr (Epi::AFTER_DRAIN) { E.fused(acc, cur, wr, wc, fr, fq, lds, wid, lane); S.done(cur); }
#undef PG8_SA
#undef PG8_SB
#undef PG8_STAGE
#undef PG8_LDA
#undef PG8_LDB
#undef PG8_MMA
#undef PG8_WAIT_V
#undef PG8_WAIT_L
#undef PG8_BAR
#undef PG8_SCHED
}
}
namespace att {
using bf16 = __hip_bfloat16;
constexpr int   D = 128, NW = 8, QBLK = 32, KVBLK = 64;
constexpr float SCALE = 0.088388347648318440f;
constexpr float THR = 8.f;
constexpr int SDEPTH = 2;
constexpr int LDQ = 2048, LDK = 512, LDO = 2048;
constexpr size_t SHM_V = KVBLK * D * 2, SHM_K = KVBLK * D * 2, SHM_ATTN = 2 * SHM_V + 2 * SHM_K + NW * 64 * 4;
using bf16x8 = __attribute__((ext_vector_type(8))) short;
using s16x4  = __attribute__((ext_vector_type(4))) short;
using f32x16 = __attribute__((ext_vector_type(16))) float;
using f32x8  = __attribute__((ext_vector_type(8))) float;
using u32x4  = __attribute__((ext_vector_type(4))) unsigned;
#define KSWZ(row, colB) ((row) * 256 + ((colB) ^ (((row) & 7) << 4)))
#define SBAR() __builtin_amdgcn_sched_barrier(0)
__device__ __forceinline__ int crow(int r, int hi) { return (r & 3) + 8 * (r >> 2) + 4 * hi; }
__device__ __forceinline__ unsigned cvtpk(float lo, float hi) { return pg8::cvt_pk_bf16(lo, hi); }
template <typename TIn> struct Stage;
template <> struct Stage<bf16>  { using T = bf16x8;
  __device__ static __forceinline__ T ld8(const bf16* p) { return *reinterpret_cast<const bf16x8*>(p); }
  __device__ static __forceinline__ bf16x8 tobf(T x) { return x; } };
template <> struct Stage<float> { using T = f32x8;
  __device__ static __forceinline__ T ld8(const float* p) { return *reinterpret_cast<const f32x8*>(p); }
  __device__ static __forceinline__ bf16x8 tobf(T x) {
    u32x4 w = {cvtpk(x[0], x[1]), cvtpk(x[2], x[3]), cvtpk(x[4], x[5]), cvtpk(x[6], x[7])}; return *reinterpret_cast<bf16x8*>(&w); } };

__device__ __forceinline__ void partialSM(f32x16& p0, f32x16& p1, float& m_reg, float& mn, float& alpha) {
  constexpr float C = SCALE * 1.4426950408889634f;
  float pmax = p0[0]; for (int r = 1; r < 16; ++r) pmax = fmaxf(pmax, p0[r]); for (int r = 0; r < 16; ++r) pmax = fmaxf(pmax, p1[r]);
  { auto rr = __builtin_amdgcn_permlane32_swap(__float_as_uint(pmax), __float_as_uint(pmax), false, false);
    pmax = fmaxf(__uint_as_float(rr[0]), __uint_as_float(rr[1])); }
  if (__builtin_expect(__all(pmax - m_reg <= THR / SCALE), 1)) { mn = m_reg; alpha = 1.f; }
  else { mn = fmaxf(m_reg, pmax); alpha = __builtin_amdgcn_exp2f((m_reg - mn) * C); m_reg = mn; }
  float mnC = -mn * C;
  for (int r = 0; r < 16; ++r) p0[r] = fmaf(p0[r], C, mnC); for (int r = 0; r < 16; ++r) p1[r] = fmaf(p1[r], C, mnC);
  for (int r = 0; r < 16; ++r) p0[r] = __builtin_amdgcn_exp2f(p0[r]);
}
__device__ __forceinline__ void finishSM(f32x16& p0, f32x16& p1, float alpha, float& l_reg, bf16x8& pa0, bf16x8& pa1, bf16x8& pa2, bf16x8& pa3) {
  for (int r = 0; r < 16; ++r) p1[r] = __builtin_amdgcn_exp2f(p1[r]);
  float ps = 0; for (int r = 0; r < 16; ++r) ps += p0[r]; for (int r = 0; r < 16; ++r) ps += p1[r];
  { auto rr = __builtin_amdgcn_permlane32_swap(__float_as_uint(ps), __float_as_uint(ps), false, false);
    ps = __uint_as_float(rr[0]) + __uint_as_float(rr[1]); }
  l_reg = l_reg * alpha + ps;
#define PK4(P, BASE, OUT) do { unsigned a0 = cvtpk(P[BASE + 0], P[BASE + 1]), a1 = cvtpk(P[BASE + 2], P[BASE + 3]);   \
    unsigned b0 = cvtpk(P[BASE + 4], P[BASE + 5]), b1 = cvtpk(P[BASE + 6], P[BASE + 7]);                              \
    auto r0 = __builtin_amdgcn_permlane32_swap(a0, b0, false, false); auto r1 = __builtin_amdgcn_permlane32_swap(a1, b1, false, false); \
    u32x4 w = {r0[0], r1[0], r0[1], r1[1]}; OUT = *reinterpret_cast<bf16x8*>(&w); } while (0)
  PK4(p0, 0, pa0); PK4(p0, 8, pa1); PK4(p1, 0, pa2); PK4(p1, 8, pa3);
#undef PK4
}
__device__ __forceinline__ void qkt(f32x16& p0, f32x16& p1, const bf16* Ks, const bf16x8* qr, int r32, int hi) {
  p0 = f32x16{}; p1 = f32x16{};
  for (int d0 = 0; d0 < 8; ++d0) { int cb = (d0 * 16 + hi * 8) * 2;
    bf16x8 b0 = *reinterpret_cast<const bf16x8*>((const char*)Ks + KSWZ(r32, cb));
    bf16x8 b1 = *reinterpret_cast<const bf16x8*>((const char*)Ks + KSWZ(32 + r32, cb));
    p0 = __builtin_amdgcn_mfma_f32_32x32x16_bf16(b0, qr[d0], p0, 0, 0, 0);
    p1 = __builtin_amdgcn_mfma_f32_32x32x16_bf16(b1, qr[d0], p1, 0, 0, 0); }
}
__device__ __forceinline__ int v_st(int k, int c) { const int kk = (k & ~0xC) | ((k & 4) << 1) | ((k & 8) >> 1); return ((kk >> 3) * 4 + (c >> 5)) * 512 + ((kk & 7) * 32 + (c & 31)) * 2; }
__device__ __forceinline__ int v_rd_base(int lane) { return ((lane & 3) << 3) | (((lane >> 2) & 3) << 6) | (((lane >> 4) & 1) << 5) | (((lane >> 5) & 1) << 8); }
constexpr int v_rd_off(int d0, int ks, int half) { return d0 * 512 + ks * 4096 + half * 2048; }
template <int OFF> __device__ __forceinline__ s16x4 tr_read(int vb) {
  s16x4 r; asm volatile("ds_read_b64_tr_b16 %0, %1 offset:%2" : "=&v"(r) : "v"(vb), "i"(OFF) : "memory"); return r;
}
template <int D0> __device__ __forceinline__ void pv_one(f32x16& od, int vb, bf16x8 pa0, bf16x8 pa1, bf16x8 pa2, bf16x8 pa3) {
  const s16x4 l0 = tr_read<v_rd_off(D0, 0, 0)>(vb), h0 = tr_read<v_rd_off(D0, 0, 1)>(vb), l1 = tr_read<v_rd_off(D0, 1, 0)>(vb), h1 = tr_read<v_rd_off(D0, 1, 1)>(vb);
  const s16x4 l2 = tr_read<v_rd_off(D0, 2, 0)>(vb), h2 = tr_read<v_rd_off(D0, 2, 1)>(vb), l3 = tr_read<v_rd_off(D0, 3, 0)>(vb), h3 = tr_read<v_rd_off(D0, 3, 1)>(vb);
  asm volatile("s_waitcnt lgkmcnt(0)" ::: "memory"); SBAR();
#define PK(L, H) (bf16x8){L[0], L[1], L[2], L[3], H[0], H[1], H[2], H[3]}
  od = __builtin_amdgcn_mfma_f32_32x32x16_bf16(pa0, PK(l0, h0), od, 0, 0, 0);
  od = __builtin_amdgcn_mfma_f32_32x32x16_bf16(pa1, PK(l1, h1), od, 0, 0, 0);
  od = __builtin_amdgcn_mfma_f32_32x32x16_bf16(pa2, PK(l2, h2), od, 0, 0, 0);
  od = __builtin_amdgcn_mfma_f32_32x32x16_bf16(pa3, PK(l3, h3), od, 0, 0, 0);
#undef PK
}
__device__ __forceinline__ void pv_d0(f32x16* o, int vb, bf16x8 pa0, bf16x8 pa1, bf16x8 pa2, bf16x8 pa3) {
  pv_one<0>(o[0], vb, pa0, pa1, pa2, pa3); pv_one<1>(o[1], vb, pa0, pa1, pa2, pa3); pv_one<2>(o[2], vb, pa0, pa1, pa2, pa3); pv_one<3>(o[3], vb, pa0, pa1, pa2, pa3);
}
template <typename TQ>
__device__ __forceinline__ void attn_dense_body(const TQ* __restrict__ Qb, const bf16* __restrict__ Kh, const bf16* __restrict__ Vh,
                                                bf16* __restrict__ Ob, int seq, char* lds) {
  using St = Stage<bf16>; using SQ = Stage<TQ>;
  int tid_ = threadIdx.x; asm volatile("" : "+v"(tid_));
  const int tid = tid_, wid = tid >> 6, lane = tid & 63, r32 = lane & 31, hi = lane >> 5;
  bf16* V_lds = (bf16*)lds; bf16* K_lds = (bf16*)(lds + 2 * SHM_V);
  float* ws = (float*)(lds + 2 * SHM_V + 2 * SHM_K) + wid * 64; float* li_l = ws; float* al_l = ws + 32;
  float m_reg = -1e30f, l_reg = 0; f32x16 o[4] = {}; bf16x8 qr[8];
  const TQ* Qw = Qb + (long)(wid * QBLK + r32) * LDQ + hi * 8;
#pragma unroll
  for (int d0 = 0; d0 < 8; ++d0) qr[d0] = SQ::tobf(SQ::ld8(Qw + d0 * 16));
  const int sr = tid >> 4, sc = (tid & 15) * 8, vst0 = v_st(sr, sc), vst1 = v_st(32 + sr, sc);
  const int vb0 = (int)(uintptr_t)V_lds + v_rd_base(lane);
  struct { typename St::T vs0, vs1, ks0, ks1; } sr_[SDEPTH];
#define SLOAD(i, k0) do { sr_[i].vs0 = St::ld8(&Vh[(long)((k0) + sr) * LDK + sc]); sr_[i].vs1 = St::ld8(&Vh[(long)((k0) + 32 + sr) * LDK + sc]); \
    sr_[i].ks0 = St::ld8(&Kh[(long)((k0) + sr) * LDK + sc]); sr_[i].ks1 = St::ld8(&Kh[(long)((k0) + 32 + sr) * LDK + sc]); } while (0)
#define SWRITE(b, i) do { *(bf16x8*)((char*)V_lds + (b) * SHM_V + vst0) = St::tobf(sr_[i].vs0);          \
    *(bf16x8*)((char*)V_lds + (b) * SHM_V + vst1) = St::tobf(sr_[i].vs1); int kc = sc * 2;               \
    *(bf16x8*)((char*)K_lds + (b) * SHM_K + KSWZ(sr, kc)) = St::tobf(sr_[i].ks0);                       \
    *(bf16x8*)((char*)K_lds + (b) * SHM_K + KSWZ(32 + sr, kc)) = St::tobf(sr_[i].ks1); } while (0)
#define SWAIT() do { if constexpr (SDEPTH == 2) asm volatile("s_waitcnt vmcnt(4)" ::: "memory"); else asm volatile("s_waitcnt vmcnt(0)" ::: "memory"); } while (0)
#define RESC(a) do { if (__any((a) < 1.f)) { if (hi == 0) al_l[r32] = (a); asm volatile("s_waitcnt lgkmcnt(0)" ::: "memory"); \
    for (int d = 0; d < 4; ++d) for (int r = 0; r < 16; ++r) o[d][r] *= al_l[crow(r, hi)]; } } while (0)
  f32x16 pA0, pA1, pB0, pB1; float mnA, mnB, alA, alB; bf16x8 pa0, pa1, pa2, pa3; const int NT = seq / KVBLK;
  constexpr int SE = 0, SO = SDEPTH - 1;
  SLOAD(SE, 0); asm volatile("s_waitcnt vmcnt(0)" ::: "memory"); SWRITE(0, SE); __syncthreads();
  qkt(pA0, pA1, K_lds, qr, r32, hi); partialSM(pA0, pA1, m_reg, mnA, alA);
  SLOAD(SO, KVBLK); if constexpr (SDEPTH == 2) { if (2 < NT) SLOAD(SE, 2 * KVBLK); }
  SWAIT(); SWRITE(1, SO); __syncthreads();
  for (int j = 1; j + 1 < NT; j += 2) {
    SBAR(); qkt(pB0, pB1, (bf16*)((char*)K_lds + SHM_K), qr, r32, hi);
    finishSM(pA0, pA1, alA, l_reg, pa0, pa1, pa2, pa3); SBAR();
    SLOAD(SO, (j + SDEPTH) * KVBLK); SBAR();
    pv_d0(o, vb0, pa0, pa1, pa2, pa3); partialSM(pB0, pB1, m_reg, mnB, alB);
    __syncthreads(); SWAIT(); SWRITE(0, SE);
    RESC(alB); __syncthreads();
    SBAR(); qkt(pA0, pA1, K_lds, qr, r32, hi);
    finishSM(pB0, pB1, alB, l_reg, pa0, pa1, pa2, pa3); SBAR();
    if (SDEPTH == 1 || j + 3 < NT) SLOAD(SE, (j + 1 + SDEPTH) * KVBLK); SBAR();
    pv_d0(o, vb0 + (int)SHM_V, pa0, pa1, pa2, pa3); partialSM(pA0, pA1, m_reg, mnA, alA);
    __syncthreads(); SWAIT(); SWRITE(1, SO);
    RESC(alA); __syncthreads();
  }
  SBAR(); qkt(pB0, pB1, (bf16*)((char*)K_lds + SHM_K), qr, r32, hi);
  finishSM(pA0, pA1, alA, l_reg, pa0, pa1, pa2, pa3); SBAR();
  pv_d0(o, vb0, pa0, pa1, pa2, pa3); partialSM(pB0, pB1, m_reg, mnB, alB);
  __syncthreads(); RESC(alB);
  finishSM(pB0, pB1, alB, l_reg, pa0, pa1, pa2, pa3); SBAR();
  pv_d0(o, vb0 + (int)SHM_V, pa0, pa1, pa2, pa3);
  if (hi == 0) li_l[r32] = l_reg; asm volatile("s_waitcnt lgkmcnt(0)" ::: "memory");
  float rli[16];
#pragma unroll
  for (int r = 0; r < 16; ++r) rli[r] = __builtin_amdgcn_rcpf(li_l[crow(r, hi)]);
  bf16* Ow = Ob + (long)(wid * QBLK) * LDO;
#pragma unroll
  for (int r = 0; r < 16; ++r) { int orow = crow(r, hi);
    for (int d0 = 0; d0 < 4; ++d0) Ow[(long)orow * LDO + d0 * 32 + r32] = __float2bfloat16(o[d0][r] * rli[r]); }
#undef SLOAD
#undef SWRITE
#undef SWAIT
#undef RESC
}
}

namespace cg = cooperative_groups;
#define LAS __attribute__((address_space(3)))
typedef pg8::bf16_t bfr;
typedef float f32x4 __attribute__((ext_vector_type(4)));
typedef float f32x2 __attribute__((ext_vector_type(2)));
typedef unsigned u32x4 __attribute__((ext_vector_type(4)));
typedef unsigned u32x2 __attribute__((ext_vector_type(2)));
typedef short bf16x8 __attribute__((ext_vector_type(8)));

constexpr int DM = 2048, SEQ = 8192, CTXL = 256, MTOT = SEQ + CTXL, DFF = 5632, INW = 11264, NMODW = 9 * DM  ;
constexpr int NWAVES = 8, NTHREADS = 512;
constexpr float EPS = 1e-6f;

constexpr size_t MiB = 1u << 20;
constexpr size_t WS_CTL = 0, CTL_ZERO_BYTES = 512 * 1024;
constexpr size_t CTL_MOD = 64 * 1024;
constexpr size_t WS_W1T = 2 * MiB, WS_W2T = 46 * MiB, WS_WINT = 68 * MiB, WS_W3T = 112 * MiB, WS_W4T = 156 * MiB;
constexpr size_t WS_WBAT = 178 * MiB, WS_WBGT = 186 * MiB, WS_WOT = 194 * MiB;
constexpr size_t WS_ROPE = 202 * MiB, WS_GVP = 206 * MiB;
constexpr size_t WS_H = 208 * MiB, WS_HID = 241 * MiB, WS_Q = 241 * MiB, WS_U = 273 * MiB, WS_T1 = WS_Q;
constexpr size_t WS_X1 = 332 * MiB, WS_ATT = 398 * MiB, WS_KA = 430 * MiB, WS_VA = 439 * MiB;
constexpr size_t WS_GV = 448 * MiB, WS_MRG = WS_GV, WS_G0 = 480 * MiB, WS_G1 = 512 * MiB, WS_END = 544 * MiB;
static_assert(WS_HID + (size_t)MTOT * DFF * 2 <= WS_X1 && WS_X1 + (size_t)MTOT * DM * 4 <= WS_ATT && WS_H + (size_t)MTOT * DM * 2 <= WS_HID, "ws map");
static_assert(WS_KA + (size_t)MTOT * 512 * 2 <= WS_VA && WS_VA + (size_t)MTOT * 512 * 2 <= WS_GV && CTL_MOD + 2 * NMODW * 4 <= CTL_ZERO_BYTES, "ws map");

constexpr int RING_BYTES = 131072, XS_OFF = RING_BYTES, MISC_OFF = XS_OFF + 8192, LDS_BYTES = 147456;
constexpr int CW_BAR = 1024;

__device__ __forceinline__ float wave_sum(float v) {
#pragma unroll
    for (int o = 1; o < 64; o <<= 1) v += __shfl_xor(v, o);
    return v;
}
__device__ __forceinline__ unsigned f2bf(float f) { unsigned u = __builtin_bit_cast(unsigned, f); return (u + 0x7fffu + ((u >> 16) & 1u)) >> 16; }
__device__ __forceinline__ unsigned pk2(float lo, float hi) { return pg8::cvt_pk_bf16(lo, hi); }
__device__ __forceinline__ float bflo(unsigned w) { return __uint_as_float(w << 16); }
__device__ __forceinline__ float bfhi(unsigned w) { return __uint_as_float(w & 0xffff0000u); }

#define XB_TMO      128
#define XB_XCNT(j)  (256  + 64 * (j))
#define XB_XSUB(j)  (1280 + 64 * (j))
#define XB_XGEN(j)  (2304 + 64 * (j))
#define XB_TOP      3328
#define XB_TOPGEN   3392
#define XCD_BAR_WORDS 3456
#define XB_SPIN_CAP (1u << 18)

__device__ __forceinline__ unsigned xb_ld(unsigned* p)              { return __hip_atomic_load(p, __ATOMIC_RELAXED, __HIP_MEMORY_SCOPE_AGENT); }
__device__ __forceinline__ unsigned xb_add(unsigned* p, unsigned v) { return __hip_atomic_fetch_add(p, v, __ATOMIC_RELAXED, __HIP_MEMORY_SCOPE_AGENT); }
__device__ __forceinline__ unsigned xb_xcc_id() { return (unsigned)__builtin_amdgcn_s_getreg((3 << 11) | 20) & 0xFu; }
#define XB_SPIN(cond, bar) do { unsigned _sp = 0; while (cond) { __builtin_amdgcn_s_sleep(1); \
    if ((++_sp & 255u) == 0u) { if (xb_ld(&(bar)[XB_TMO])) break; if (_sp > XB_SPIN_CAP) { atomicAdd(&(bar)[XB_TMO], 1u); break; } } } } while (0)

struct XcdBarrier {
    unsigned* bar; unsigned x;
    volatile LAS unsigned* st;
};

__device__ __forceinline__ XcdBarrier xcd_barrier_post(unsigned* bar, volatile LAS unsigned* st) {
    XcdBarrier b; b.bar = bar; b.x = xb_xcc_id(); b.st = st;
    if (threadIdx.x == 0) (void)xb_add(&bar[XB_XCNT(b.x)], 1u);
    return b;
}
__device__ __forceinline__ void xcd_barrier_complete(unsigned* bar, unsigned x, unsigned& nloc, unsigned& nx) {
    const unsigned G = gridDim.x * gridDim.y * gridDim.z;
    unsigned sum, cnt, mine, sp = 0u;
    for (;;) {
        sum = 0u; cnt = 0u; mine = 0u;
#pragma unroll
        for (unsigned j = 0; j < 16; ++j) { const unsigned c = xb_ld(&bar[XB_XCNT(j)]); sum += c; cnt += (c > 0u) ? 1u : 0u; mine = (j == x) ? c : mine; }
        if (sum == G) break;
        __builtin_amdgcn_s_sleep(1);
        if ((++sp & 255u) == 0u) { if (xb_ld(&bar[XB_TMO])) break; if (sp > XB_SPIN_CAP) { atomicAdd(&bar[XB_TMO], 1u); break; } }
    }
    nloc = mine > 0u ? mine : 1u; nx = cnt > 0u ? cnt : 1u;
}

__device__ __forceinline__ void xcd_barrier(const XcdBarrier& b) {
    asm volatile("s_waitcnt vmcnt(0)" ::: "memory");
    __syncthreads();
    if (threadIdx.x == 0) {
        unsigned* bar = b.bar;
        __builtin_amdgcn_s_waitcnt(0);
        unsigned nloc = b.st[0], nx = b.st[1];
        if (nloc == 0u) { xcd_barrier_complete(bar, b.x, nloc, nx); b.st[0] = nloc; b.st[1] = nx; }
        const unsigned old = xb_add(&bar[XB_XSUB(b.x)], 1u);
        const unsigned gen = old / nloc;
        if (old + 1u == (gen + 1u) * nloc) {
            __builtin_amdgcn_fence(__ATOMIC_RELEASE, "agent");
            asm volatile("s_waitcnt vmcnt(0)" ::: "memory");
            const unsigned og = xb_add(&bar[XB_TOP], 1u);
            const unsigned tg = og / nx;
            if (og + 1u == (tg + 1u) * nx) xb_add(&bar[XB_TOPGEN], 1u);
            else XB_SPIN(xb_ld(&bar[XB_TOPGEN]) == tg, bar);
            __builtin_amdgcn_fence(__ATOMIC_ACQUIRE, "agent");
            xb_add(&bar[XB_XGEN(b.x)], 1u);
            asm volatile("s_waitcnt vmcnt(0)" ::: "memory");
        } else {
            XB_SPIN(xb_ld(&bar[XB_XGEN(b.x)]) == gen, bar);
            __builtin_amdgcn_fence(__ATOMIC_ACQUIRE, "agent");
            asm volatile("s_waitcnt vmcnt(0)" ::: "memory");
        }
    }
    __syncthreads();
}

template <int MODE> __device__ __forceinline__ void transpose_item(const float* __restrict__ W, int K, int N, bfr* WT, LAS float* scr, int item, int lane) {
    const int nblk = N / 32, kb = item / nblk, nb = item % nblk, k0 = 64 * kb, n0 = 32 * nb;
    int d0 = n0;
    if (MODE == 1) { const int F = N / 2; const int nn = n0 < F ? n0 : n0 - F; d0 = (nn / 128) * 256 + (n0 < F ? 0 : 128) + (nn % 128); }
#pragma unroll 8
    for (int i = 0; i < 32; ++i) { const int kk = 2 * i + (lane >> 5); scr[kk * 33 + (lane & 31)] = W[(size_t)(k0 + kk) * N + n0 + (lane & 31)]; }
    asm volatile("s_waitcnt lgkmcnt(0)" ::: "memory");
    const int c = lane & 7;
#pragma unroll
    for (int j = 0; j < 4; ++j) { const int n = (lane >> 3) + 8 * j; const LAS float* s = scr + (8 * c) * 33 + n;
        u32x4 o; o.x = pk2(s[0 * 33], s[1 * 33]); o.y = pk2(s[2 * 33], s[3 * 33]); o.z = pk2(s[4 * 33], s[5 * 33]); o.w = pk2(s[6 * 33], s[7 * 33]);
        *(u32x4*)(WT + (size_t)(d0 + n) * K + k0 + 8 * c) = o; }
    asm volatile("s_waitcnt lgkmcnt(0)" ::: "memory");
}

__device__ __forceinline__ void norm_mod_row(const float* xrow, const float* nw, const float* ms, const float* bs, const float* mc, const float* bc, bfr* orow, int lane) {
    const f32x4* xr = (const f32x4*)xrow + lane;
    f32x4 v[8]; float ss = 0.f;
#pragma unroll
    for (int j = 0; j < 8; ++j) { v[j] = xr[64 * j]; ss += (v[j][0] * v[j][0] + v[j][1] * v[j][1]) + (v[j][2] * v[j][2] + v[j][3] * v[j][3]); }
    const float rinv = 1.0f / sqrtf(wave_sum(ss) * (1.0f / DM) + EPS);
    u32x2* o8 = (u32x2*)orow + lane;
#pragma unroll
    for (int j = 0; j < 8; ++j) { const int c4 = lane + 64 * j;
        const f32x4 w = ((const f32x4*)nw)[c4], sh = ((const f32x4*)ms)[c4] + ((const f32x4*)bs)[c4], sc = ((const f32x4*)mc)[c4] + ((const f32x4*)bc)[c4];
        const f32x4 y = (v[j] * rinv * w) * (sc + 1.0f) + sh;
        u32x2 p; p.x = pk2(y[0], y[1]); p.y = pk2(y[2], y[3]); o8[64 * j] = p; }
}

__device__ __forceinline__ void spatial_unit(LAS unsigned char* lds, int c, int g, const bfr* GV, const float* GVP, const bfr* U, bfr* GM,
                                             const float* wsp, const float* bsp, const float* lnw, const float* lnb, int tid, int lane, int wave) {
    constexpr int PITCH = 136;
    LAS bfr* Al = (LAS bfr*)lds;
    LAS bfr* Vt = (LAS bfr*)(lds + 128 * PITCH * 2);
    LAS float* st = (LAS float*)(lds + 2 * 128 * PITCH * 2);
    const int R0 = c * 128, C0 = g * 128;
    if (tid < 128) { const float* p = GVP + (size_t)(R0 + tid) * 64; float s1 = 0.f, s2 = 0.f;
#pragma unroll 8
        for (int k = 0; k < 32; ++k) { s1 += p[2 * k]; s2 += p[2 * k + 1]; }
        const float mu = s1 * (1.0f / 2048.0f), var = s2 * (1.0f / 2048.0f) - mu * mu;
        st[2 * tid] = mu; st[2 * tid + 1] = 1.0f / sqrtf(fmaxf(var, 0.f) + EPS); }
#pragma unroll
    for (int i = 0; i < 4; ++i) { const int e = tid + 512 * i, p = e >> 4, q0 = (e & 15) * 8; const float* w = wsp + ((size_t)g * 128 + p) * 128 + q0;
        const f32x4 a = *(const f32x4*)w, b = *(const f32x4*)(w + 4);
        u32x4 o; o.x = pk2(a[0], a[1]); o.y = pk2(a[2], a[3]); o.z = pk2(b[0], b[1]); o.w = pk2(b[2], b[3]);
        *(LAS u32x4*)(Al + p * PITCH + q0) = o; }
    __syncthreads();
#pragma unroll
    for (int i = 0; i < 4; ++i) { const int e = tid + 512 * i, q = e >> 4, d0 = (e & 15) * 8;
        const u32x4 x = *(const u32x4*)(GV + (size_t)(R0 + q) * 2048 + C0 + d0);
        const float mu = st[2 * q], rs = st[2 * q + 1];
        const f32x4 lw0 = *(const f32x4*)(lnw + C0 + d0), lw1 = *(const f32x4*)(lnw + C0 + d0 + 4), lb0 = *(const f32x4*)(lnb + C0 + d0), lb1 = *(const f32x4*)(lnb + C0 + d0 + 4);
        float v[8] = {bflo(x.x), bfhi(x.x), bflo(x.y), bfhi(x.y), bflo(x.z), bfhi(x.z), bflo(x.w), bfhi(x.w)};
#pragma unroll
        for (int j = 0; j < 8; ++j) { const float lw = j < 4 ? lw0[j & 3] : lw1[j & 3], lb = j < 4 ? lb0[j & 3] : lb1[j & 3];
            Vt[(d0 + j) * PITCH + q] = (bfr)f2bf((v[j] - mu) * rs * lw + lb); } }
    __syncthreads();
    f32x4 acc[8];
#pragma unroll
    for (int db = 0; db < 8; ++db) acc[db] = (f32x4){0.f, 0.f, 0.f, 0.f};
    const int l15 = lane & 15, l4 = lane >> 4;
#pragma unroll
    for (int kb = 0; kb < 4; ++kb) {
        const bf16x8 bfrag = *(const LAS bf16x8*)(Al + (16 * wave + l15) * PITCH + kb * 32 + 8 * l4);
#pragma unroll
        for (int db = 0; db < 8; ++db) { const bf16x8 afrag = *(const LAS bf16x8*)(Vt + (16 * db + l15) * PITCH + kb * 32 + 8 * l4);
            acc[db] = __builtin_amdgcn_mfma_f32_16x16x32_bf16(afrag, bfrag, acc[db], 0, 0, 0); }
    }
    const int pl = 16 * wave + l15; const float bp = bsp[g * 128 + pl];
    const size_t rowoff = (size_t)(R0 + pl) * 2048 + C0 + 4 * l4;
#pragma unroll
    for (int db = 0; db < 8; ++db) { const u32x2 uw = *(const u32x2*)(U + rowoff + 16 * db);
        u32x2 o; o.x = pk2(bflo(uw.x) * (acc[db][0] + bp), bfhi(uw.x) * (acc[db][1] + bp)); o.y = pk2(bflo(uw.y) * (acc[db][2] + bp), bfhi(uw.y) * (acc[db][3] + bp));
        *(u32x2*)(GM + rowoff + 16 * db) = o; }
    __syncthreads();
}

struct InProjOrder {
    pg8::StaticOrder base; int nextra;
    __device__ __forceinline__ bool next(int i, pg8::Unit& u) const {
        if (base.next(i, u)) return true;
        const long L = (long)i * base.G + base.c - base.nwg; if (L >= nextra) return false;
        u.pm = 32; u.pn = 8 + (int)L; return true;
    }
    __device__ __forceinline__ void a_ready(const pg8::Unit&) const {}
    __device__ __forceinline__ void done(const pg8::Unit&) const {}
};


#ifndef DBG_DUMP
#define DBG_DUMP 0
#endif
#define BFV(p, i) __uint_as_float(((unsigned)(p)[i]) << 16)
#define DUMP_AND_RETURN(EXPR) do { for (size_t e_ = (size_t)bx * NTHREADS + tid; e_ < (size_t)SEQ * DM; e_ += (size_t)G * NTHREADS) { const size_t r = e_ / DM, c = e_ % DM; (void)r; (void)c; a.out[e_] = (EXPR); } return; } while (0)
struct FfnOutOrder {
    pg8::StaticOrder base;
    __device__ __forceinline__ bool next(int i, pg8::Unit& u) const {
        if (base.next(i, u)) { u.kt0 = 0; u.nkt = 0; return true; }
        const long L = (long)i * base.G + base.c - base.nwg; if (L >= 88) return false;
        u.pm = 32; u.pn = (int)(L & 7); u.kt0 = (int)(L >> 3) * 8; u.nkt = 8; return true;
    }
    __device__ __forceinline__ void a_ready(const pg8::Unit&) const {}
    __device__ __forceinline__ void done(const pg8::Unit&) const {}
};
constexpr int NKS = 11;

__device__ __forceinline__ void norm_mod_row_ctx(const float* crow, const float* slab_r, const float* mg, const float* bg, const float* nw, const float* ms, const float* bs, const float* mc, const float* bc, bfr* orow, int lane) {
    f32x4 v[8]; float ss = 0.f;
#pragma unroll
    for (int j = 0; j < 8; ++j) { const int c4 = lane + 64 * j; f32x4 p = {0.f, 0.f, 0.f, 0.f};
#pragma unroll
        for (int s = 0; s < NKS; ++s) p += ((const f32x4*)(slab_r + (size_t)s * 256 * 2048))[c4];
        const f32x4 g = (((const f32x4*)mg)[c4] + ((const f32x4*)bg)[c4]) * 0.5f;
        v[j] = ((const f32x4*)crow)[c4] + g * p;
        ss += (v[j][0] * v[j][0] + v[j][1] * v[j][1]) + (v[j][2] * v[j][2] + v[j][3] * v[j][3]); }
    const float rinv = 1.0f / sqrtf(wave_sum(ss) * (1.0f / DM) + EPS);
    u32x2* o8 = (u32x2*)orow + lane;
#pragma unroll
    for (int j = 0; j < 8; ++j) { const int c4 = lane + 64 * j;
        const f32x4 w = ((const f32x4*)nw)[c4], sh = ((const f32x4*)ms)[c4] + ((const f32x4*)bs)[c4], sc = ((const f32x4*)mc)[c4] + ((const f32x4*)bc)[c4];
        const f32x4 y = (v[j] * rinv * w) * (sc + 1.0f) + sh;
        u32x2 p; p.x = pk2(y[0], y[1]); p.y = pk2(y[2], y[3]); o8[64 * j] = p; }
}

struct Args { const float* in[23]; float* out; unsigned char* ws; };

__global__ void __launch_bounds__(NTHREADS, 2) fwd_kernel(Args a) {
    extern __shared__ __attribute__((aligned(16))) unsigned char lds_raw[];
    LAS unsigned char* lds = (LAS unsigned char*)lds_raw;
    cg::grid_group grid = cg::this_grid();
    const int tid = threadIdx.x, lane = tid & 63, wave = __builtin_amdgcn_readfirstlane(tid >> 6);
    const int G = gridDim.x, bx = blockIdx.x;
    const int vcu = (G % 8 == 0) ? (bx % 8) * (G / 8) + bx / 8 : bx;
    const int gw = vcu * NWAVES + wave, NGW = G * NWAVES;
    unsigned char* ws = a.ws;
    const float* x = a.in[0]; const float* cvec = a.in[1]; const float* ctx = a.in[2]; const float* cctx = a.in[3];
    const float* w_mod = a.in[4]; const float* b_mod = a.in[5]; const float* norm_w = a.in[6];
    const float* w_spatial = a.in[17]; const float* b_spatial = a.in[18];
    float* MOD = (float*)(ws + WS_CTL + CTL_MOD);
    bfr* W1T = (bfr*)(ws + WS_W1T); bfr* W2T = (bfr*)(ws + WS_W2T); bfr* WINT = (bfr*)(ws + WS_WINT); bfr* W3T = (bfr*)(ws + WS_W3T); bfr* W4T = (bfr*)(ws + WS_W4T);
    bfr* WBAT = (bfr*)(ws + WS_WBAT); bfr* WBGT = (bfr*)(ws + WS_WBGT); bfr* WOT = (bfr*)(ws + WS_WOT);
    float* ROPE = (float*)(ws + WS_ROPE); float* GVP = (float*)(ws + WS_GVP);
    bfr* H = (bfr*)(ws + WS_H); bfr* HID = (bfr*)(ws + WS_HID); bfr* Qb = (bfr*)(ws + WS_Q); bfr* Ub = (bfr*)(ws + WS_U); bfr* T1 = (bfr*)(ws + WS_T1);
    float* X1 = (float*)(ws + WS_X1); bfr* ATT = (bfr*)(ws + WS_ATT); bfr* KA = (bfr*)(ws + WS_KA); bfr* VA = (bfr*)(ws + WS_VA);
    float* SLAB = (float*)(ws + WS_ATT);
    bfr* GVb = (bfr*)(ws + WS_GV); bfr* MRG = (bfr*)(ws + WS_MRG); bfr* G0 = (bfr*)(ws + WS_G0); bfr* G1 = (bfr*)(ws + WS_G1);

    if (tid < 2) ((volatile LAS unsigned*)(lds + MISC_OFF))[tid] = 0u;
    __syncthreads();
    XcdBarrier xbar = xcd_barrier_post((unsigned*)(ws + WS_CTL) + CW_BAR, (volatile LAS unsigned*)(lds + MISC_OFF));
#ifdef TPROBE
    unsigned long long* TS = (unsigned long long*)(ws + WS_CTL + 32768);
    int stamp_k = 0;
#define GRID_SYNC() do { xcd_barrier(xbar); if (bx == 0 && tid == 0) TS[++stamp_k] = __builtin_amdgcn_s_memrealtime(); } while (0)
#else
#define GRID_SYNC() xcd_barrier(xbar)
#endif
    grid.sync();
#ifdef TPROBE
    if (bx == 0 && tid == 0) TS[0] = __builtin_amdgcn_s_memrealtime();
#endif
#define GRID_SYNC_CG() do { asm volatile("s_waitcnt vmcnt(0)" ::: "memory"); __syncthreads(); grid.sync(); \
        if (tid == 0) { __builtin_amdgcn_fence(__ATOMIC_ACQUIRE, "agent"); asm volatile("s_waitcnt vmcnt(0)" ::: "memory"); } __syncthreads(); } while (0)

    {
        LAS float* red = (LAS float*)lds;
        for (int task = bx; task < 72 * 32; task += G) {
            const int cgp = task % 72, ks = task / 72, k0 = ks * 64 + wave * 8;
            const float* wp = w_mod + (size_t)k0 * NMODW + cgp * 256 + lane * 4;
            f32x4 a0 = {0.f, 0.f, 0.f, 0.f}, a1 = {0.f, 0.f, 0.f, 0.f};
#pragma unroll
            for (int r = 0; r < 8; ++r) { const f32x4 w = *(const f32x4*)(wp + (size_t)r * NMODW);
                const float cv = cvec[k0 + r], cc = cctx[k0 + r];
                const float s0 = cv / (1.0f + __expf(-cv)), s1 = cc / (1.0f + __expf(-cc));
                a0 += w * s0; a1 += w * s1; }
            *(LAS f32x4*)(red + (wave * 64 + lane) * 8) = a0; *(LAS f32x4*)(red + (wave * 64 + lane) * 8 + 4) = a1;
            __syncthreads();
            { const int v = tid >> 8, col = tid & 255; float s = 0.f;
#pragma unroll
              for (int w = 0; w < 8; ++w) s += red[(w * 64 + (col >> 2)) * 8 + v * 4 + (col & 3)];
              atomicAdd(MOD + v * NMODW + cgp * 256 + col, s); }
            __syncthreads();
        }
        LAS float* scr = (LAS float*)(lds + wave * 16384);
        constexpr int I_FI = (DM / 64) * (2 * DFF / 32), I_FO = (DFF / 64) * (DM / 32), I_IN = (DM / 64) * (INW / 32), I_SQ = (DM / 64) * (DM / 32);
        constexpr int NITEMS = 2 * I_FI + 2 * I_FO + I_IN + 3 * I_SQ;
        for (int it = gw; it < NITEMS; it += NGW) {
            int r = it;
            if (r < I_FI) { transpose_item<1>(a.in[7], DM, 2 * DFF, W1T, scr, r, lane); continue; } r -= I_FI;
            if (r < I_FO) { transpose_item<0>(a.in[8], DFF, DM, W2T, scr, r, lane); continue; } r -= I_FO;
            if (r < I_IN) { transpose_item<0>(a.in[11], DM, INW, WINT, scr, r, lane); continue; } r -= I_IN;
            if (r < I_FI) { transpose_item<1>(a.in[9], DM, 2 * DFF, W3T, scr, r, lane); continue; } r -= I_FI;
            if (r < I_FO) { transpose_item<0>(a.in[10], DFF, DM, W4T, scr, r, lane); continue; } r -= I_FO;
            if (r < I_SQ) { transpose_item<0>(a.in[19], DM, DM, WBAT, scr, r, lane); continue; } r -= I_SQ;
            if (r < I_SQ) { transpose_item<0>(a.in[20], DM, DM, WBGT, scr, r, lane); continue; } r -= I_SQ;
            transpose_item<0>(a.in[21], DM, DM, WOT, scr, r, lane);
        }
        for (int idx = bx * NTHREADS + tid; idx < SEQ * 64; idx += G * NTHREADS) {
            const int t = idx >> 6, i = idx & 63, f = i & 31;
            const float pos = (float)(i < 32 ? (t >> 6) : (t & 63));
            const float inv = powf(10000.0f, -(float)(2 * f) / 64.0f);
            float sn, cs; sincosf(pos * inv, &sn, &cs);
            *(f32x2*)(ROPE + (size_t)t * 128 + 2 * i) = (f32x2){cs, sn};
        }
    }
    GRID_SYNC();

    if (DBG_DUMP == 90) DUMP_AND_RETURN(a.in[12][c] + a.in[12][2048 + c] + a.in[13][c & 127] + a.in[14][c & 127] + a.in[15][c] + a.in[16][c] + a.in[5][c] + a.in[6][c] + a.in[22][c] + a.in[18][c] + a.in[1][c] + a.in[3][c]);
    for (int m = gw; m < MTOT; m += NGW) {
        const int v = m < SEQ ? 0 : 1; const float* xr = m < SEQ ? x + (size_t)m * DM : ctx + (size_t)(m - SEQ) * DM;
        norm_mod_row(xr, norm_w, MOD + v * NMODW, b_mod, MOD + v * NMODW + DM, b_mod + DM, H + (size_t)m * DM, lane);
    }
    GRID_SYNC();

    if (DBG_DUMP == 1) DUMP_AND_RETURN(BFV(H, e_) + BFV(W1T, e_) + BFV(WINT, e_ + 4096u * 2048u) + MOD[e_ % 36864]);
    { pg8::Gemm g{H, W1T, MTOT, 2 * DFF, DM}; pg8::StaticOrder S; S.init(MTOT, 2 * DFF, G, bx);
      pg8::EpiSwiglu E{HID, DFF};
      pg8::gemm_phase<pg8::EpiSwiglu, pg8::StaticOrder, true, true>(lds, g, S, E); }
    GRID_SYNC();

    if (DBG_DUMP == 2) DUMP_AND_RETURN(BFV(HID, r * 5632 + c) + BFV(HID, r * 5632 + 2048 + c) + (r < 256 ? BFV(HID, (8192 + r) * 5632 + 3000 + c) : 0.f));
    { pg8::Gemm g{HID, W2T, MTOT, DM, DFF}; FfnOutOrder S; S.base.init(SEQ, DM, G, bx);
      pg8::EpiResidSplit E{x, ctx, X1, MOD, b_mod, SLAB};
      pg8::gemm_phase<pg8::EpiResidSplit, FfnOutOrder, true, true>(lds, g, S, E); }
    GRID_SYNC();

#ifndef STOP_AFTER
#define STOP_AFTER 99
#endif
    if (STOP_AFTER >= 8) {
    for (int m = gw; m < MTOT; m += NGW) {
        if (m < SEQ) norm_mod_row(X1 + (size_t)m * DM, norm_w + DM, MOD + 3 * DM, b_mod + 3 * DM, MOD + 4 * DM, b_mod + 4 * DM, H + (size_t)m * DM, lane);
        else norm_mod_row_ctx(ctx + (size_t)(m - SEQ) * DM, SLAB + (size_t)(m - SEQ) * DM, MOD + NMODW + 2 * DM, b_mod + 2 * DM, norm_w + DM,
                              MOD + NMODW + 3 * DM, b_mod + 3 * DM, MOD + NMODW + 4 * DM, b_mod + 4 * DM, H + (size_t)m * DM, lane);
    }
    GRID_SYNC();

    { pg8::Gemm g{H, WINT, MTOT, INW, DM}; InProjOrder S; S.base.init(SEQ, INW, G, bx); S.nextra = 4;
      pg8::EpiInProj E{Qb, KA, VA, Ub, GVb, G0, G1, GVP, ROPE, a.in[13], a.in[14], a.in[12], (LAS float*)(lds + XS_OFF), SEQ};
      pg8::gemm_phase<pg8::EpiInProj, InProjOrder, true, true>(lds, g, S, E); }
    GRID_SYNC();

    if (DBG_DUMP == 5) DUMP_AND_RETURN(BFV(Qb, e_) + BFV(Ub, e_) + BFV(GVb, e_) + BFV(G0, e_) + BFV(G1, e_) + BFV(KA, r * 512 + (c & 511)) + BFV(VA, r * 512 + (c & 511)) + (c < 64 ? GVP[r * 64 + c] : 0.f) + (r < 256 ? BFV(KA, (8192 + r) * 512 + (c & 511)) + BFV(VA, (8192 + r) * 512 + (c & 511)) : 0.f));
    if (DBG_DUMP == 51) DUMP_AND_RETURN(BFV(Qb, e_));
    if (DBG_DUMP == 52) DUMP_AND_RETURN(BFV(KA, r * 512 + (c & 511)) + BFV(VA, r * 512 + (c & 511)) + (r < 256 ? BFV(KA, (8192 + r) * 512 + (c & 511)) + BFV(VA, (8192 + r) * 512 + (c & 511)) : 0.f));
    if (DBG_DUMP == 53) DUMP_AND_RETURN(BFV(Ub, e_) + BFV(GVb, e_) + (c < 64 ? GVP[r * 64 + c] : 0.f));
    if (DBG_DUMP == 54) DUMP_AND_RETURN(BFV(G0, e_) + BFV(G1, e_));
    if (DBG_DUMP == 55) DUMP_AND_RETURN(BFV(H, e_) + (r < 256 ? BFV(H, (8192 + r) * 2048 + c) : 0.f));
    for (int uidx = vcu; uidx < 512; uidx += G) {
        const int h = uidx >> 5, qb = uidx & 31, kvh = h >> 2;
        att::attn_dense_body<att::bf16>((const att::bf16*)Qb + (size_t)qb * 256 * DM + h * 128, (const att::bf16*)KA + kvh * 128, (const att::bf16*)VA + kvh * 128,
                                        (att::bf16*)ATT + (size_t)qb * 256 * DM + h * 128, MTOT, (char*)lds_raw);
        __syncthreads();
    }
    for (int uidx = vcu; uidx < 1024; uidx += G)
        spatial_unit(lds, uidx >> 4, uidx & 15, GVb, GVP, Ub, Ub, w_spatial, b_spatial, a.in[15], a.in[16], tid, lane, wave);
    GRID_SYNC();

    if (DBG_DUMP == 6) DUMP_AND_RETURN(BFV(ATT, e_) + BFV(Ub, e_));
    if (DBG_DUMP == 61) DUMP_AND_RETURN(BFV(ATT, e_));
    if (DBG_DUMP == 62) DUMP_AND_RETURN(BFV(Ub, e_));
    { pg8::Gemm g{ATT, WBAT, SEQ, DM, DM}; pg8::StaticOrder S; S.init(SEQ, DM, G, bx);
      pg8::EpiGate<false> E{G0, nullptr, T1};
      pg8::gemm_phase<pg8::EpiGate<false>, pg8::StaticOrder, true, true>(lds, g, S, E); }
    GRID_SYNC();
    { pg8::Gemm g{Ub, WBGT, SEQ, DM, DM}; pg8::StaticOrder S; S.init(SEQ, DM, G, bx);
      pg8::EpiGate<true> E{G1, T1, MRG};
      pg8::gemm_phase<pg8::EpiGate<true>, pg8::StaticOrder, true, true>(lds, g, S, E); }
    GRID_SYNC();
    if (DBG_DUMP == 7) DUMP_AND_RETURN(BFV(MRG, e_));
    { pg8::Gemm g{MRG, WOT, SEQ, DM, DM}; pg8::StaticOrder S; S.init(SEQ, DM, G, bx);
      pg8::EpiResid E{X1, X1, X1, MOD, b_mod, 5, 1.0f, SEQ};
      pg8::gemm_phase<pg8::EpiResid, pg8::StaticOrder, true, true>(lds, g, S, E); }
    GRID_SYNC();
    }
    if (STOP_AFTER >= 11) {
    for (int m = gw; m < SEQ; m += NGW)
        norm_mod_row(X1 + (size_t)m * DM, norm_w + 2 * DM, MOD + 6 * DM, b_mod + 6 * DM, MOD + 7 * DM, b_mod + 7 * DM, H + (size_t)m * DM, lane);
    GRID_SYNC();
    { pg8::Gemm g{H, W3T, SEQ, 2 * DFF, DM}; pg8::StaticOrder S; S.init(SEQ, 2 * DFF, G, bx);
      pg8::EpiSwiglu E{HID, DFF};
      pg8::gemm_phase<pg8::EpiSwiglu, pg8::StaticOrder, true, true>(lds, g, S, E); }
    GRID_SYNC();
    { pg8::Gemm g{HID, W4T, SEQ, DM, DFF}; pg8::StaticOrder S; S.init(SEQ, DM, G, bx);
      pg8::EpiResid E{X1, X1, X1, MOD, b_mod, 8, 0.5f, SEQ};
      pg8::gemm_phase<pg8::EpiResid, pg8::StaticOrder, true, true>(lds, g, S, E); }
    GRID_SYNC();
    }
    if (DBG_DUMP == 91) DUMP_AND_RETURN(a.in[12][c] + a.in[12][2048 + c] + a.in[13][c & 127] + a.in[14][c & 127] + a.in[15][c] + a.in[16][c] + a.in[5][c] + a.in[6][c] + a.in[22][c] + a.in[18][c] + a.in[1][c] + a.in[3][c]);
    for (int m = gw; m < SEQ; m += NGW) {
        const f32x4* xr = (const f32x4*)(X1 + (size_t)m * DM) + lane; const f32x4* fw = (const f32x4*)a.in[22] + lane;
        f32x4 v[8]; float ss = 0.f;
#pragma unroll
        for (int j = 0; j < 8; ++j) { v[j] = xr[64 * j]; ss += (v[j][0] * v[j][0] + v[j][1] * v[j][1]) + (v[j][2] * v[j][2] + v[j][3] * v[j][3]); }
        const float rinv = 1.0f / sqrtf(wave_sum(ss) * (1.0f / DM) + EPS);
        f32x4* o = (f32x4*)(a.out + (size_t)m * DM) + lane;
#pragma unroll
        for (int j = 0; j < 8; ++j) o[64 * j] = v[j] * rinv * fw[64 * j];
    }
#ifdef TPROBE
    asm volatile("s_waitcnt vmcnt(0)" ::: "memory"); __syncthreads();
    if (bx == 0 && tid == 0) { const unsigned long long t_end = __builtin_amdgcn_s_memrealtime(); TS[14] = t_end;
        const unsigned long long extra = (unsigned long long)(TPW) * (TS[TPA1] - TS[TPA0]);
        while (__builtin_amdgcn_s_memrealtime() - t_end < extra) __builtin_amdgcn_s_sleep(32); }
#endif
}

extern "C" void kernel_launch(void* const* d_in, const int* in_sizes, int n_in, void* d_out, int out_size, void* d_ws, size_t ws_size, hipStream_t stream) {
    static int grid = 0;
    if (grid == 0) {
        if (n_in != 23 || in_sizes[0] != SEQ * DM || out_size != SEQ * DM || ws_size < WS_END) {
            fprintf(stderr, "kernel_launch: shape mismatch: n_in %d in0 %d out %d ws %zu (need %zu)\n", n_in, n_in > 0 ? in_sizes[0] : -1, out_size, ws_size, (size_t)WS_END); grid = -1; return; }
        int dev = 0, cus = 0, per_cu = 0;
        if (hipGetDevice(&dev) != hipSuccess || hipDeviceGetAttribute(&cus, hipDeviceAttributeMultiprocessorCount, dev) != hipSuccess) { fprintf(stderr, "kernel_launch: device query failed\n"); grid = -1; return; }
        if (hipFuncSetAttribute((const void*)fwd_kernel, hipFuncAttributeMaxDynamicSharedMemorySize, LDS_BYTES) != hipSuccess) { fprintf(stderr, "kernel_launch: hipFuncSetAttribute failed\n"); grid = -1; return; }
        if (hipOccupancyMaxActiveBlocksPerMultiprocessor(&per_cu, (const void*)fwd_kernel, NTHREADS, LDS_BYTES) != hipSuccess || per_cu < 1) { fprintf(stderr, "kernel_launch: occupancy query says %d blocks per CU\n", per_cu); (void)hipGetLastError(); grid = -1; return; }
        grid = cus * 1;
    }
    if (grid < 0) return;
    (void)hipMemsetAsync((char*)d_ws + WS_CTL, 0, CTL_ZERO_BYTES, stream);
    Args a{};
    for (int i = 0; i < 23; ++i) a.in[i] = (const float*)d_in[i];
    a.out = (float*)d_out; a.ws = (unsigned char*)d_ws;
    void* args[] = {&a};
    const hipError_t e = hipLaunchCooperativeKernel((const void*)fwd_kernel, dim3(grid), dim3(NTHREADS), args, LDS_BYTES, stream);
    if (e != hipSuccess) fprintf(stderr, "kernel_launch: cooperative launch failed: %s (grid %d)\n", hipGetErrorString(e), grid);
}
```
